# Optimizing an MI355X kernel written in HIP

```python
import math
import jax, jax.numpy as jnp
from jax import lax
import numpy as np

D_MODEL = 2048
BATCH = 1
SEQ = 8192
DEPTH = 4

MLA_HEADS = 8
MLA_NOPE_DIM = 128
MLA_ROPE_DIM = 64
MLA_V_DIM = 128
MLA_QK_DIM = MLA_NOPE_DIM + MLA_ROPE_DIM
MLA_Q_RANK = 512
MLA_KV_RANK = 512
ROPE_THETA = 10000.0
ATTN_BLOCK = 128
GDN_HEADS = 8
GDN_HEAD_DIM = 128
GDN_DIM = GDN_HEADS * GDN_HEAD_DIM
GDN_CONV = 4
GDN_CHUNK = 64
GLA_HEADS = 4
GLA_KEY_DIM = D_MODEL // 2
GLA_VALUE_DIM = D_MODEL
GLA_HEAD_K = GLA_KEY_DIM // GLA_HEADS
GLA_HEAD_V = GLA_VALUE_DIM // GLA_HEADS
GLA_GATE_RANK = 16
GLA_GATE_NORMALIZER = 16.0
GLA_CHUNK = 64
D_FF = -(-8 * D_MODEL // (3 * 256)) * 256
MLA_IN = MLA_Q_RANK + MLA_KV_RANK + MLA_ROPE_DIM
GDN_IN = 4 * GDN_DIM + 2 * GDN_HEADS
EVEN_IN = MLA_IN + GDN_IN
EVEN_MIX = MLA_HEADS * MLA_V_DIM + GDN_DIM
GLA_IN = 2 * GLA_KEY_DIM + 2 * GLA_VALUE_DIM + GLA_GATE_RANK
N_EVEN = (DEPTH + 1) // 2
N_ODD = DEPTH // 2
EPS = 1e-6

kernel_name = "hybrid_mla_gdn_gla_adaln_trunk"


def rms_norm(x, gain):
    xf = x.astype(jnp.float32)
    y = xf * lax.rsqrt(jnp.mean(xf * xf, axis=-1, keepdims=True) + EPS)
    return (y * gain.astype(jnp.float32)).astype(x.dtype)


def l2_norm(x):
    xf = x.astype(jnp.float32)
    return xf * lax.rsqrt(jnp.sum(xf * xf, axis=-1, keepdims=True) + EPS)


def split_cols(t, sizes):
    return jnp.split(t, np.cumsum(sizes)[:-1].tolist(), axis=-1)


def ada_modulation(c, w, b):
    m = (jax.nn.silu(c) @ w + b)[:, None, :]
    return jnp.split(m, 3, axis=-1)


def rope_tables(positions):
    half = MLA_ROPE_DIM // 2
    inv_freq = ROPE_THETA ** (-jnp.arange(half, dtype=jnp.float32) / half)
    ang = positions.astype(jnp.float32)[..., None] * inv_freq
    return jnp.cos(ang), jnp.sin(ang)


def apply_rope(x, cos, sin):
    x1, x2 = jnp.split(x.astype(jnp.float32), 2, axis=-1)
    return jnp.concatenate([x1 * cos - x2 * sin, x2 * cos + x1 * sin], axis=-1)


def causal_depthwise_conv(x, w):
    k_width, s = w.shape[0], x.shape[1]
    xp = jnp.pad(x, ((0, 0), (k_width - 1, 0), (0, 0)))
    y = xp[:, 0:s] * w[0]
    for j in range(1, k_width):
        y = y + xp[:, j:j + s] * w[j]
    return y


def causal_block_attention(q, k, v):
    b, h, s, dqk = q.shape
    nb = s // ATTN_BLOCK
    scale = 1.0 / math.sqrt(dqk)
    qb = jnp.moveaxis(q.reshape(b, h, nb, ATTN_BLOCK, dqk), 2, 0)
    kpos = jnp.arange(s)

    def one_block(args):
        q_blk, i = args
        qpos = i * ATTN_BLOCK + jnp.arange(ATTN_BLOCK)
        sc = jnp.einsum('bhqd,bhkd->bhqk', q_blk, k) * scale
        sc = jnp.where(kpos[None, :] <= qpos[:, None], sc, -jnp.inf)
        p = jax.nn.softmax(sc, axis=-1)
        return jnp.einsum('bhqk,bhkd->bhqd', p, v)

    o = lax.map(one_block, (qb, jnp.arange(nb)))
    return jnp.moveaxis(o, 0, 2).reshape(b, h, s, v.shape[-1])


def mla_branch(c_q, c_kv, k_rope, cos, sin, q_norm, w_uq, kv_norm, w_ukv):
    b, s, _ = c_q.shape
    q = (rms_norm(c_q, q_norm) @ w_uq).reshape(b, s, MLA_HEADS, MLA_QK_DIM)
    kv = (rms_norm(c_kv, kv_norm) @ w_ukv).reshape(b, s, MLA_HEADS, MLA_NOPE_DIM + MLA_V_DIM)
    q_nope, q_rope = q[..., :MLA_NOPE_DIM], q[..., MLA_NOPE_DIM:]
    k_nope, v = kv[..., :MLA_NOPE_DIM], kv[..., MLA_NOPE_DIM:]
    q_rope = apply_rope(q_rope, cos[:, :, None, :], sin[:, :, None, :])
    k_rope = apply_rope(k_rope, cos, sin)
    q = jnp.concatenate([q_nope.astype(jnp.float32), q_rope], axis=-1)
    k = jnp.concatenate([k_nope.astype(jnp.float32),
                         jnp.broadcast_to(k_rope[:, :, None, :], (b, s, MLA_HEADS, MLA_ROPE_DIM))], axis=-1)
    o = causal_block_attention(q.transpose(0, 2, 1, 3), k.transpose(0, 2, 1, 3),
                               v.astype(jnp.float32).transpose(0, 2, 1, 3))
    return o.transpose(0, 2, 1, 3).reshape(b, s, MLA_HEADS * MLA_V_DIM)


def gated_delta_rule_chunked(q, k, v, g, beta):
    b, h, s, dk = q.shape
    dv = v.shape[-1]
    cs, n = GDN_CHUNK, s // GDN_CHUNK
    q = q * (1.0 / math.sqrt(dk))
    q, k, v = (t.reshape(b, h, n, cs, t.shape[-1]) for t in (q, k, v))
    g, beta = g.reshape(b, h, n, cs), beta.reshape(b, h, n, cs)
    gc = jnp.cumsum(g, axis=-1)
    incl = jnp.tril(jnp.ones((cs, cs), dtype=bool))
    strict = jnp.tril(jnp.ones((cs, cs), dtype=bool), -1)
    decay = jnp.exp(jnp.where(incl, gc[..., :, None] - gc[..., None, :], -jnp.inf))
    k_beta = k * beta[..., None]
    lower = jnp.where(strict, jnp.einsum('bhnid,bhnjd->bhnij', k_beta, k) * decay, 0.0)
    t_mat = jnp.eye(cs, dtype=q.dtype) + lower
    rhs = jnp.concatenate([v * beta[..., None], k_beta * jnp.exp(gc)[..., None]], axis=-1)
    sol = lax.linalg.triangular_solve(t_mat, rhs, left_side=True, lower=True, unit_diagonal=True)
    u, w = sol[..., :dv], sol[..., dv:]
    intra = jnp.einsum('bhnid,bhnjd->bhnij', q, k) * decay
    g_last = gc[..., -1]
    k_dec = k * jnp.exp(g_last[..., None] - gc)[..., None]
    q_dec = q * jnp.exp(gc)[..., None]

    def step(state, inp):
        q_d, k_d, u_c, w_c, a_c, gl = inp
        v_new = u_c - jnp.einsum('bhcd,bhde->bhce', w_c, state)
        o = jnp.einsum('bhcd,bhde->bhce', q_d, state) + jnp.einsum('bhij,bhje->bhie', a_c, v_new)
        state = state * jnp.exp(gl)[..., None, None] + jnp.einsum('bhcd,bhce->bhde', k_d, v_new)
        return state, o

    xs = tuple(jnp.moveaxis(t, 2, 0) for t in (q_dec, k_dec, u, w, intra, g_last))
    _, o = lax.scan(step, jnp.zeros((b, h, dk, dv), q.dtype), xs)
    return jnp.moveaxis(o, 0, 2).reshape(b, h, s, dv)


def gdn_branch(qkv, z, b_logit, a_logit, conv_w, a_log, dt_bias, norm_g):
    bsz, s, _ = qkv.shape
    qkv = jax.nn.silu(causal_depthwise_conv(qkv, conv_w))
    q, k, v = jnp.split(qkv, 3, axis=-1)
    heads = lambda t: t.reshape(bsz, s, GDN_HEADS, GDN_HEAD_DIM)
    q, k = l2_norm(heads(q)), l2_norm(heads(k))
    v = heads(v).astype(jnp.float32)
    beta = jax.nn.sigmoid(b_logit.astype(jnp.float32))
    g = -jnp.exp(a_log.astype(jnp.float32)) * jax.nn.softplus(a_logit.astype(jnp.float32) + dt_bias)
    o = gated_delta_rule_chunked(q.transpose(0, 2, 1, 3), k.transpose(0, 2, 1, 3), v.transpose(0, 2, 1, 3),
                                 g.transpose(0, 2, 1), beta.transpose(0, 2, 1))
    o = rms_norm(o.transpose(0, 2, 1, 3), norm_g) * jax.nn.silu(heads(z).astype(jnp.float32))
    return o.reshape(bsz, s, GDN_DIM)


def ab_mixer(h, cos, sin, w_in, q_norm, w_uq, kv_norm, w_ukv, conv_w, a_log, dt_bias, gdn_norm, w_out):
    proj = h @ w_in
    c_q, c_kv, k_rope, qkv, z, b_logit, a_logit = split_cols(
        proj, [MLA_Q_RANK, MLA_KV_RANK, MLA_ROPE_DIM, 3 * GDN_DIM, GDN_DIM, GDN_HEADS, GDN_HEADS])
    o_a = mla_branch(c_q, c_kv, k_rope, cos, sin, q_norm, w_uq, kv_norm, w_ukv)
    o_b = gdn_branch(qkv, z, b_logit, a_logit, conv_w, a_log, dt_bias, gdn_norm)
    return jnp.concatenate([o_a, o_b], axis=-1).astype(h.dtype) @ w_out


def gla_chunked(q, k, v, gk):
    b, h, s, dk = q.shape
    dv = v.shape[-1]
    cs, n = GLA_CHUNK, s // GLA_CHUNK
    q = q * (1.0 / math.sqrt(dk))
    chunks = lambda t: jnp.moveaxis(t.reshape(b, h, n, cs, t.shape[-1]), 2, 0)
    bc = jnp.cumsum(gk.reshape(b, h, n, cs, dk), axis=3)
    causal = jnp.tril(jnp.ones((cs, cs), dtype=bool))[:, :, None]

    def step(state, inp):
        q_c, k_c, v_c, b_c = inp
        o_inter = jnp.einsum('bhcd,bhde->bhce', q_c * jnp.exp(b_c), state)
        rel = jnp.exp(jnp.where(causal, b_c[:, :, :, None, :] - b_c[:, :, None, :, :], -jnp.inf))
        scores = jnp.einsum('bhid,bhjd,bhijd->bhij', q_c, k_c, rel)
        o = o_inter + jnp.einsum('bhij,bhje->bhie', scores, v_c)
        b_last = b_c[:, :, -1:, :]
        state = state * jnp.exp(b_last[:, :, 0, :, None]) + jnp.einsum('bhcd,bhce->bhde', k_c * jnp.exp(b_last - b_c), v_c)
        return state, o

    _, o = lax.scan(step, jnp.zeros((b, h, dk, dv), q.dtype),
                    (chunks(q), chunks(k), chunks(v), jnp.moveaxis(bc, 2, 0)))
    return jnp.moveaxis(o, 0, 2).reshape(b, h, s, dv)


def gla_mixer(h, w_in, w_gk2, b_gk2, norm_g, w_out):
    bsz, s, _ = h.shape
    q, k, v, r, gk_low = split_cols(h @ w_in, [GLA_KEY_DIM, GLA_KEY_DIM, GLA_VALUE_DIM, GLA_VALUE_DIM, GLA_GATE_RANK])
    gk = jax.nn.log_sigmoid((gk_low @ w_gk2 + b_gk2).astype(jnp.float32)) / GLA_GATE_NORMALIZER
    hk = lambda t: t.astype(jnp.float32).reshape(bsz, s, GLA_HEADS, GLA_HEAD_K).transpose(0, 2, 1, 3)
    hv = lambda t: t.astype(jnp.float32).reshape(bsz, s, GLA_HEADS, GLA_HEAD_V).transpose(0, 2, 1, 3)
    o = gla_chunked(hk(q), hk(k), hv(v), hk(gk)).transpose(0, 2, 1, 3)
    o = rms_norm(o, norm_g) * jax.nn.silu(r.astype(jnp.float32).reshape(bsz, s, GLA_HEADS, GLA_HEAD_V))
    return o.reshape(bsz, s, GLA_VALUE_DIM).astype(h.dtype) @ w_out


def swiglu(h, w1, w3, w2):
    return (jax.nn.silu(h @ w1) * (h @ w3)) @ w2


def setup_inputs(seed: int = 0) -> dict:
    key = jax.random.key(seed)
    ks = iter(jax.random.split(key, 32))
    nrm = lambda shape, std: jax.random.normal(next(ks), shape, jnp.float32) * std
    gain = lambda shape: 1.0 + nrm(shape, 0.02)
    offset = jax.random.randint(next(ks), (BATCH, 1), 0, 1024, dtype=jnp.int32)
    positions = offset + jnp.arange(SEQ, dtype=jnp.int32)[None, :]
    a_log = jnp.log(jax.random.uniform(next(ks), (N_EVEN, GDN_HEADS), jnp.float32, 1.0, 16.0))
    dt = jnp.exp(jax.random.uniform(next(ks), (N_EVEN, GDN_HEADS), jnp.float32, math.log(1e-3), math.log(1e-1)))
    dt_bias = dt + jnp.log(-jnp.expm1(-dt))
    return {
        "x": nrm((BATCH, SEQ, D_MODEL), 1.0),
        "c": nrm((BATCH, D_MODEL), 1.0),
        "positions": positions,
        "norm_g": gain((DEPTH, 2, D_MODEL)),
        "ada_w": nrm((DEPTH, 2, D_MODEL, 3 * D_MODEL), 0.5 * D_MODEL ** -0.5),
        "ada_b": nrm((DEPTH, 2, 3 * D_MODEL), 0.01),
        "ab_w_in": nrm((N_EVEN, D_MODEL, EVEN_IN), D_MODEL ** -0.5),
        "mla_q_norm": gain((N_EVEN, MLA_Q_RANK)),
        "mla_w_uq": nrm((N_EVEN, MLA_Q_RANK, MLA_HEADS * MLA_QK_DIM), MLA_Q_RANK ** -0.5),
        "mla_kv_norm": gain((N_EVEN, MLA_KV_RANK)),
        "mla_w_ukv": nrm((N_EVEN, MLA_KV_RANK, MLA_HEADS * (MLA_NOPE_DIM + MLA_V_DIM)), MLA_KV_RANK ** -0.5),
        "gdn_conv_w": nrm((N_EVEN, GDN_CONV, 3 * GDN_DIM), GDN_CONV ** -0.5),
        "gdn_a_log": a_log,
        "gdn_dt_bias": dt_bias,
        "gdn_norm": gain((N_EVEN, GDN_HEAD_DIM)),
        "ab_w_out": nrm((N_EVEN, EVEN_MIX, D_MODEL), EVEN_MIX ** -0.5),
        "gla_w_in": nrm((N_ODD, D_MODEL, GLA_IN), D_MODEL ** -0.5),
        "gla_w_gk2": nrm((N_ODD, GLA_GATE_RANK, GLA_KEY_DIM), GLA_GATE_RANK ** -0.5),
        "gla_b_gk2": nrm((N_ODD, GLA_KEY_DIM), 0.01),
        "gla_norm": gain((N_ODD, GLA_HEAD_V)),
        "gla_w_out": nrm((N_ODD, GLA_VALUE_DIM, D_MODEL), GLA_VALUE_DIM ** -0.5),
        "ffn_w1": nrm((DEPTH, D_MODEL, D_FF), D_MODEL ** -0.5),
        "ffn_w3": nrm((DEPTH, D_MODEL, D_FF), D_MODEL ** -0.5),
        "ffn_w2": nrm((DEPTH, D_FF, D_MODEL), D_FF ** -0.5),
        "final_norm": gain((D_MODEL,)),
    }


def reference(x, c, positions, norm_g, ada_w, ada_b, ab_w_in, mla_q_norm, mla_w_uq, mla_kv_norm, mla_w_ukv,
              gdn_conv_w, gdn_a_log, gdn_dt_bias, gdn_norm, ab_w_out, gla_w_in, gla_w_gk2, gla_b_gk2, gla_norm,
              gla_w_out, ffn_w1, ffn_w3, ffn_w2, final_norm):
    cos, sin = rope_tables(positions)
    for layer in range(DEPTH):
        i = layer // 2
        shift, scale, gate = ada_modulation(c, ada_w[layer, 0], ada_b[layer, 0])
        h = rms_norm(x, norm_g[layer, 0]) * (1.0 + scale) + shift
        if layer % 2 == 0:
            mix = ab_mixer(h, cos, sin, ab_w_in[i], mla_q_norm[i], mla_w_uq[i], mla_kv_norm[i], mla_w_ukv[i],
                           gdn_conv_w[i], gdn_a_log[i], gdn_dt_bias[i], gdn_norm[i], ab_w_out[i])
        else:
            mix = gla_mixer(h, gla_w_in[i], gla_w_gk2[i], gla_b_gk2[i], gla_norm[i], gla_w_out[i])
        x = x + gate * mix
        shift, scale, gate = ada_modulation(c, ada_w[layer, 1], ada_b[layer, 1])
        h = rms_norm(x, norm_g[layer, 1]) * (1.0 + scale) + shift
        x = x + gate * swiglu(h, ffn_w1[layer], ffn_w3[layer], ffn_w2[layer])
    return rms_norm(x, final_norm)
```

```cpp
#include <hip/hip_runtime.h>
#include <cstdio>
#include <cstdint>
#define MK_PER_PHASE 1

namespace pg8 {
#define PG8_LAS __attribute__((address_space(3)))
typedef unsigned short bf16_t;
typedef short bf16x8 __attribute__((ext_vector_type(8)));
typedef float f32x4 __attribute__((ext_vector_type(4)));
typedef unsigned u32x4 __attribute__((ext_vector_type(4)));
constexpr int BM = 256, BK = 64, HALF = 128, HTB = HALF * BK * 2  , STAGE_BYTES = 8 * HTB, NXCD = 8, WGM = 8;

__host__ __device__ __forceinline__ int lds_byte(int r, int c) { const int st = (r >> 4) * 2 + (c >> 5), rr = r & 15, cc = c & 31, ob = rr * 64 + cc * 2; return st * 1024 + (ob ^ (((ob >> 9) & 1) << 5)); }
__host__ __device__ __forceinline__ void stage_rc(int b, int& R, int& C) { const int st = b / 1024, sb = b % 1024, swz = sb ^ (((sb >> 9) & 1) << 5); R = (st >> 1) * 16 + swz / 64; C = (st & 1) * 32 + (swz % 64) / 2; }
__host__ __device__ __forceinline__ int perm32(int rho) { const int n = rho >> 4, i = rho & 15; return 8 * (i >> 2) + 4 * n + (i & 3); }

struct Unit { int pm, pn; };
struct Gemm { const bf16_t* A; const bf16_t* Bt; int M, N, K; };

struct StaticOrder {
    int nM, nN, nwg, G, c;
    __host__ __device__ void init(int M, int N, int G_, int c_) { nM = M / BM; nN = N / BM; nwg = nM * nN; G = G_; c = c_; }
    __host__ __device__ bool next(int i, Unit& u) const {
        const long L = (long)i * G + c; if (L >= nwg) return false;
        int wgid = (int)L; { const int q = nwg / NXCD, r = nwg % NXCD, xcd = wgid % NXCD, off = wgid / NXCD; wgid = (xcd < r ? xcd * (q + 1) : r * (q + 1) + (xcd - r) * q) + off; }
        const int nig = WGM * nN, gid = wgid / nig, fm = gid * WGM, gsz = (nM - fm) < WGM ? (nM - fm) : WGM;
        u.pm = fm + ((wgid % nig) % gsz); u.pn = (wgid % nig) / gsz; return true;
    }
    __device__ __forceinline__ void a_ready(const Unit&) const {}
    __device__ __forceinline__ void done(const Unit&) const {}
};

__device__ __forceinline__ unsigned cvt_pk_bf16(float lo, float hi) { unsigned r; asm volatile("v_cvt_pk_bf16_f32 %0, %1, %2" : "=v"(r) : "v"(lo), "v"(hi)); return r; }
typedef float f32x2 __attribute__((ext_vector_type(2)));
__device__ __forceinline__ u32x4 pack8(const f32x4& a, const f32x4& b) { u32x4 w; w.x = cvt_pk_bf16(a[0], a[1]); w.y = cvt_pk_bf16(a[2], a[3]); w.z = cvt_pk_bf16(b[0], b[1]); w.w = cvt_pk_bf16(b[2], b[3]); return w; }
__device__ __forceinline__ float sumsq4(const f32x4& a) { return (a[0] * a[0] + a[1] * a[1]) + (a[2] * a[2] + a[3] * a[3]); }
__device__ __forceinline__ void rope8(f32x4& v0, f32x4& v1, const f32x4& c4, const f32x4& s4) {
    const f32x4 a = v0, b = v1;
    v0[0] = a[0] * c4[0] - a[1] * s4[0]; v0[1] = a[1] * c4[0] + a[0] * s4[0];
    v0[2] = a[2] * c4[1] - a[3] * s4[1]; v0[3] = a[3] * c4[1] + a[2] * s4[1];
    v1[0] = b[0] * c4[2] - b[1] * s4[2]; v1[1] = b[1] * c4[2] + b[0] * s4[2];
    v1[2] = b[2] * c4[3] - b[3] * s4[3]; v1[3] = b[3] * c4[3] + b[2] * s4[3];
}
constexpr int TOK = 8192;
struct EpiEvenIn {
    static constexpr bool PERM = true, AFTER_DRAIN = false;
    bf16_t *CQ, *CKV, *QKV, *Z, *KH; float *SSQ, *BA; const float *cosT, *sinT;
    __device__ __forceinline__ void operator()(const f32x4 (&acc)[2][2][4][2], const Unit& u, int wr, int wc, int fr_in, int fq_in) const {
        int fr = fr_in, fq = fq_in; asm volatile("" : "+v"(fr), "+v"(fq));
        const int row0 = u.pm * BM + wr * 64 + fr;
        if (u.pn < 20) {
            bf16_t* base; int ldc, colt;
            if (u.pn < 2) { base = CQ; ldc = 512; colt = u.pn * 256; } else if (u.pn < 4) { base = CKV; ldc = 512; colt = (u.pn - 2) * 256; }
            else if (u.pn < 16) { base = QKV; ldc = 3072; colt = (u.pn - 4) * 256; } else { base = Z; ldc = 1024; colt = (u.pn - 16) * 256; }
            const int col0 = colt + wc * 32 + 8 * fq;
#pragma unroll
            for (int ai = 0; ai < 2; ++ai)
#pragma unroll
                for (int m = 0; m < 4; ++m) { const int row = row0 + ai * HALF + m * 16; bf16_t* rowp = base + (size_t)row * ldc + col0; float ss = 0.f;
#pragma unroll
                    for (int bj = 0; bj < 2; ++bj) { const f32x4 v0 = acc[ai][bj][m][0], v1 = acc[ai][bj][m][1]; ss += sumsq4(v0) + sumsq4(v1); *(u32x4*)(rowp + bj * HALF) = pack8(v0, v1); }
                    if (u.pn < 4) { const int ln = fq * 16 + fr; ss += __builtin_bit_cast(float, __builtin_amdgcn_ds_bpermute((ln ^ 16) << 2, __builtin_bit_cast(int, ss))); ss += __builtin_bit_cast(float, __builtin_amdgcn_ds_bpermute((ln ^ 32) << 2, __builtin_bit_cast(int, ss))); if (fq == 0) SSQ[(size_t)row * 16 + u.pn * 4 + wc] = ss; } }
        } else {
            if (wc < 2) {
#pragma unroll
                for (int ai = 0; ai < 2; ++ai)
#pragma unroll
                    for (int m = 0; m < 4; ++m) { const int row = row0 + ai * HALF + m * 16; f32x4 v0 = acc[ai][0][m][0], v1 = acc[ai][0][m][1];
                        const int i0 = 16 * wc + 4 * fq; const f32x4 c4 = *(const f32x4*)(cosT + (size_t)row * 32 + i0), s4 = *(const f32x4*)(sinT + (size_t)row * 32 + i0);
                        rope8(v0, v1, c4, s4); const u32x4 w = pack8(v0, v1);
#pragma unroll
                        for (int h = 0; h < 8; ++h) *(u32x4*)(KH + ((size_t)h * TOK + row) * 192 + 128 + 32 * wc + 8 * fq) = w; }
            } else if (wc == 2) {
                if (fq < 2) {
#pragma unroll
                    for (int ai = 0; ai < 2; ++ai)
#pragma unroll
                        for (int m = 0; m < 4; ++m) { const int row = row0 + ai * HALF + m * 16; float* p = BA + (size_t)row * 16 + 8 * fq; *(f32x4*)p = acc[ai][0][m][0]; *(f32x4*)(p + 4) = acc[ai][0][m][1]; }
                }
            }
        }
    }
};
struct EpiUq {
    static constexpr bool PERM = true, AFTER_DRAIN = false;
    bf16_t* QH; const float* SSQ; const float *cosT, *sinT; float qscale;
    __device__ __forceinline__ void operator()(const f32x4 (&acc)[2][2][4][2], const Unit& u, int wr, int wc, int fr_in, int fq_in) const {
        int fr = fr_in, fq = fq_in; asm volatile("" : "+v"(fr), "+v"(fq));
        const int row0 = u.pm * BM + wr * 64 + fr;
#pragma unroll
        for (int ai = 0; ai < 2; ++ai)
#pragma unroll
            for (int m = 0; m < 4; ++m) { const int row = row0 + ai * HALF + m * 16;
                const f32x4 p0 = *(const f32x4*)(SSQ + (size_t)row * 16), p1 = *(const f32x4*)(SSQ + (size_t)row * 16 + 4);
                const float ssum = ((p0[0] + p0[1]) + (p0[2] + p0[3])) + ((p1[0] + p1[1]) + (p1[2] + p1[3]));
                const float rq = rsqrtf(ssum * (1.0f / 512.0f) + 1e-6f) * qscale;
#pragma unroll
                for (int bj = 0; bj < 2; ++bj) { const int c8 = u.pn * BM + bj * HALF + wc * 32 + 8 * fq; const int head = c8 / 192, d = c8 - head * 192;
                    f32x4 v0 = acc[ai][bj][m][0] * rq, v1 = acc[ai][bj][m][1] * rq;
                    if (d >= 128) { const int i0 = (d - 128) >> 1; const f32x4 c4 = *(const f32x4*)(cosT + (size_t)row * 32 + i0), s4 = *(const f32x4*)(sinT + (size_t)row * 32 + i0); rope8(v0, v1, c4, s4); }
                    *(u32x4*)(QH + ((size_t)head * TOK + row) * 192 + d) = pack8(v0, v1); } }
    }
};
struct EpiUkv {
    static constexpr bool PERM = true, AFTER_DRAIN = false;
    bf16_t *KH, *VT; const float* SSQ;
    __device__ __forceinline__ void operator()(const f32x4 (&acc)[2][2][4][2], const Unit& u, int wr, int wc, int fr_in, int fq_in) const {
        int fr = fr_in, fq = fq_in; asm volatile("" : "+v"(fr), "+v"(fq));
        const int row0 = u.pm * BM + wr * 64 + fr, head = u.pn;
#pragma unroll
        for (int ai = 0; ai < 2; ++ai)
#pragma unroll
            for (int m = 0; m < 4; ++m) { const int row = row0 + ai * HALF + m * 16;
                const f32x4 p0 = *(const f32x4*)(SSQ + (size_t)row * 16 + 8), p1 = *(const f32x4*)(SSQ + (size_t)row * 16 + 12);
                const float ssum = ((p0[0] + p0[1]) + (p0[2] + p0[3])) + ((p1[0] + p1[1]) + (p1[2] + p1[3]));
                const float rk = rsqrtf(ssum * (1.0f / 512.0f) + 1e-6f);
                { const f32x4 v0 = acc[ai][0][m][0] * rk, v1 = acc[ai][0][m][1] * rk; *(u32x4*)(KH + ((size_t)head * TOK + row) * 192 + wc * 32 + 8 * fq) = pack8(v0, v1); }
                { const f32x4 v0 = acc[ai][1][m][0] * rk, v1 = acc[ai][1][m][1] * rk; const u32x4 w = pack8(v0, v1); bf16_t* vp = VT + ((size_t)head * 128 + wc * 32 + 8 * fq) * TOK + row;
                  vp[0 * TOK] = (bf16_t)(w.x & 0xffffu); vp[1 * TOK] = (bf16_t)(w.x >> 16); vp[2 * TOK] = (bf16_t)(w.y & 0xffffu); vp[3 * TOK] = (bf16_t)(w.y >> 16);
                  vp[4 * TOK] = (bf16_t)(w.z & 0xffffu); vp[5 * TOK] = (bf16_t)(w.z >> 16); vp[6 * TOK] = (bf16_t)(w.w & 0xffffu); vp[7 * TOK] = (bf16_t)(w.w >> 16); } }
    }
};
struct EpiOddIn {
    static constexpr bool PERM = true, AFTER_DRAIN = false;
    bf16_t *Q, *K, *V, *R;
    __device__ __forceinline__ void operator()(const f32x4 (&acc)[2][2][4][2], const Unit& u, int wr, int wc, int fr_in, int fq_in) const {
        int fr = fr_in, fq = fq_in; asm volatile("" : "+v"(fr), "+v"(fq));
        const int row0 = u.pm * BM + wr * 64 + fr;
        bf16_t* base; int ldc, colt;
        if (u.pn < 4) { base = Q; ldc = 1024; colt = u.pn * 256; } else if (u.pn < 8) { base = K; ldc = 1024; colt = (u.pn - 4) * 256; }
        else if (u.pn < 16) { base = V; ldc = 2048; colt = (u.pn - 8) * 256; } else { base = R; ldc = 2048; colt = (u.pn - 16) * 256; }
        const int col0 = colt + wc * 32 + 8 * fq;
#pragma unroll
        for (int ai = 0; ai < 2; ++ai)
#pragma unroll
            for (int m = 0; m < 4; ++m) { bf16_t* rowp = base + (size_t)(row0 + ai * HALF + m * 16) * ldc + col0;
#pragma unroll
                for (int bj = 0; bj < 2; ++bj) *(u32x4*)(rowp + bj * HALF) = pack8(acc[ai][bj][m][0], acc[ai][bj][m][1]); }
    }
};
struct EpiResid {
    static constexpr bool PERM = false, AFTER_DRAIN = false;
    const float* xin; float* xout; const float* gate;
    __device__ __forceinline__ void operator()(const f32x4 (&acc)[2][2][4][2], const Unit& u, int wr, int wc, int fr_in, int fq_in) const {
        int fr = fr_in, fq = fq_in; asm volatile("" : "+v"(fr), "+v"(fq));
        const int row0 = u.pm * BM + wr * 64 + fr, col0 = u.pn * BM + wc * 32 + 4 * fq;
        f32x4 gv[2][2];
#pragma unroll
        for (int bj = 0; bj < 2; ++bj)
#pragma unroll
            for (int n = 0; n < 2; ++n) gv[bj][n] = *(const f32x4*)(gate + col0 + bj * HALF + n * 16);
#pragma unroll
        for (int ai = 0; ai < 2; ++ai)
#pragma unroll
            for (int m = 0; m < 4; ++m) { const size_t off = (size_t)(row0 + ai * HALF + m * 16) * 2048 + col0;
#pragma unroll
                for (int bj = 0; bj < 2; ++bj)
#pragma unroll
                    for (int n = 0; n < 2; ++n) { const f32x4 x = *(const f32x4*)(xin + off + bj * HALF + n * 16); *(f32x4*)(xout + off + bj * HALF + n * 16) = x + gv[bj][n] * acc[ai][bj][m][n]; } }
    }
};
struct EpiFfnUp {
    static constexpr bool PERM = true, AFTER_DRAIN = false;
    bf16_t* HID;
    __device__ __forceinline__ void operator()(const f32x4 (&acc)[2][2][4][2], const Unit& u, int wr, int wc, int fr_in, int fq_in) const {
        int fr = fr_in, fq = fq_in; asm volatile("" : "+v"(fr), "+v"(fq));
        const int row0 = u.pm * BM + wr * 64 + fr, colh = u.pn * 128 + wc * 32 + 8 * fq;
#pragma unroll
        for (int ai = 0; ai < 2; ++ai)
#pragma unroll
            for (int m = 0; m < 4; ++m) { f32x4 h4[2];
#pragma unroll
                for (int bj = 0; bj < 2; ++bj) { const f32x4 a = acc[ai][bj][m][0], b = acc[ai][bj][m][1];
#pragma unroll
                    for (int j = 0; j < 4; ++j) h4[bj][j] = a[j] * __builtin_amdgcn_rcpf(1.0f + __builtin_amdgcn_exp2f(-1.4426950408889634f * a[j])) * b[j]; }
                *(u32x4*)(HID + (size_t)(row0 + ai * HALF + m * 16) * 5632 + colh) = pack8(h4[0], h4[1]); }
    }
};
template <class Epi, class Sched, bool ALIGN_EPI = false, bool SP2 = false>
__device__ __forceinline__ void gemm_phase(PG8_LAS unsigned char* lds, const Gemm g, const Sched& S, const Epi& E) {
    int tid_l = threadIdx.x; asm volatile("" : "+v"(tid_l));
    const int tid = tid_l, wid = __builtin_amdgcn_readfirstlane(tid >> 6), lane = tid & 63, wr = wid >> 2, wc = wid & 3, fr = lane & 15, fq = lane >> 4;
    const int K = g.K, nt = K / BK;
    unsigned voffA[2], voffB[2];
#pragma unroll
    for (int i = 0; i < 2; ++i) { int R, C; stage_rc(tid * 16 + i * 8192, R, C); const int Rb = Epi::PERM ? ((R & ~31) + perm32(R & 31)) : R;
        voffA[i] = (unsigned)(R * K + C) * 2u; voffB[i] = (unsigned)(Rb * K + C) * 2u; }
    const size_t kstep = (size_t)(BK * 2);
    const size_t hstep = (size_t)HALF * K * 2;
    const size_t tstep = 2 * hstep;
    const unsigned ldsw = (unsigned)wid * 1024u;
    const int aoff = lds_byte(wr * 64 + fr, fq * 8), boff = lds_byte(wc * 32 + fr, fq * 8);
#define PG8_SA(b, h) (((b) * 2 + (h)) * HTB)
#define PG8_SB(b, h) ((4 + (b) * 2 + (h)) * HTB)
#define PG8_STAGE(bufoff, gbase, voff) do { _Pragma("unroll") for (int _i = 0; _i < 2; ++_i) \
        __builtin_amdgcn_global_load_lds((const unsigned*)((const char*)(gbase) + (voff)[_i]), (PG8_LAS unsigned*)(lds + (bufoff) + ldsw + _i * 8192), 16, 0, 0); } while (0)
#define PG8_LDA(dst, b, h) do { _Pragma("unroll") for (int m = 0; m < 4; ++m) _Pragma("unroll") for (int k = 0; k < 2; ++k) dst[m][k] = *(const PG8_LAS bf16x8*)(lds + PG8_SA(b, h) + aoff + m * 2048 + k * 1024); } while (0)
#define PG8_LDB(dst, b, h) do { _Pragma("unroll") for (int n = 0; n < 2; ++n) _Pragma("unroll") for (int k = 0; k < 2; ++k) dst[n][k] = *(const PG8_LAS bf16x8*)(lds + PG8_SB(b, h) + boff + n * 2048 + k * 1024); } while (0)
#define PG8_MMA(ai, bj, At, Bt) do { __builtin_amdgcn_s_setprio(1); _Pragma("unroll") for (int m = 0; m < 4; ++m) _Pragma("unroll") for (int n = 0; n < 2; ++n) _Pragma("unroll") for (int k = 0; k < 2; ++k) \
        acc[ai][bj][m][n] = __builtin_amdgcn_mfma_f32_16x16x32_bf16(Bt[n][k], At[m][k], acc[ai][bj][m][n], 0, 0, 0); __builtin_amdgcn_s_setprio(0); } while (0)
#define PG8_WAIT_V(n) asm volatile("s_waitcnt vmcnt(" #n ")" ::: "memory")
#define PG8_WAIT_L(n) asm volatile("s_waitcnt lgkmcnt(" #n ")" ::: "memory")
#define PG8_BAR __builtin_amdgcn_s_barrier()
#define PG8_SCHED __builtin_amdgcn_sched_barrier(0)
    Unit cur, nxt; int ui = 0;
    if (!S.next(0, cur)) return;
    f32x4 acc[2][2][4][2];
#pragma unroll
    for (int a = 0; a < 2; ++a)
#pragma unroll
        for (int b = 0; b < 2; ++b)
#pragma unroll
            for (int m = 0; m < 4; ++m)
#pragma unroll
                for (int n = 0; n < 2; ++n) acc[a][b][m][n] = (f32x4){0.f, 0.f, 0.f, 0.f};
    bf16x8 At[4][2], B0[2][2], B1[2][2];
    const char* cA = (const char*)g.A + (size_t)cur.pm * tstep; const char* cB = (const char*)g.Bt + (size_t)cur.pn * tstep;
    S.a_ready(cur);
    if constexpr (SP2) {
        PG8_STAGE(PG8_SB(0, 0), cB, voffB); PG8_STAGE(PG8_SB(0, 1), cB + hstep, voffB); PG8_STAGE(PG8_SA(0, 0), cA, voffA); PG8_STAGE(PG8_SA(0, 1), cA + hstep, voffA);
        if (wr == 1) PG8_BAR;
        PG8_WAIT_V(2); PG8_BAR;
        PG8_STAGE(PG8_SB(1, 0), cB + kstep, voffB); PG8_STAGE(PG8_SA(1, 0), cA + kstep, voffA); PG8_STAGE(PG8_SB(1, 1), cB + hstep + kstep, voffB);
        PG8_WAIT_V(6); PG8_BAR;
    } else {
        PG8_STAGE(PG8_SB(0, 0), cB, voffB); PG8_STAGE(PG8_SA(0, 0), cA, voffA); PG8_STAGE(PG8_SB(0, 1), cB + hstep, voffB); PG8_STAGE(PG8_SA(0, 1), cA + hstep, voffA);
        if (wr == 1) PG8_BAR;
        PG8_WAIT_V(4); PG8_BAR;
        PG8_STAGE(PG8_SB(1, 0), cB + kstep, voffB); PG8_STAGE(PG8_SA(1, 0), cA + kstep, voffA); PG8_STAGE(PG8_SB(1, 1), cB + hstep + kstep, voffB);
        PG8_WAIT_V(6); PG8_BAR;
    }
    for (;;) {
        const bool has_next = S.next(ui + 1, nxt);
        const char* nA = has_next ? (const char*)g.A + (size_t)nxt.pm * tstep : cA; const char* nB = has_next ? (const char*)g.Bt + (size_t)nxt.pn * tstep : cB;
        for (int t = 0; t < nt; t += 2) {
            const bool last = (t == nt - 2);
            const char* a1 = cA + (size_t)(t + 1) * kstep;
            const char* a2 = last ? nA : cA + (size_t)(t + 2) * kstep; const char* b2 = last ? nB : cB + (size_t)(t + 2) * kstep;
            const char* a3 = a2 + kstep; const char* b3 = b2 + kstep;
            if (last && has_next) S.a_ready(nxt);
            if constexpr (SP2) {
            PG8_LDB(B0, 0, 0); PG8_LDB(B1, 0, 1); PG8_SCHED; PG8_LDA(At, 0, 0); PG8_STAGE(PG8_SA(1, 1), a1 + hstep, voffA);
            PG8_WAIT_V(8); PG8_WAIT_L(0); PG8_BAR; PG8_MMA(0, 0, At, B0); PG8_MMA(0, 1, At, B1); PG8_BAR; PG8_SCHED;
            PG8_LDA(At, 0, 1); PG8_STAGE(PG8_SB(0, 0), b2, voffB); PG8_STAGE(PG8_SB(0, 1), b2 + hstep, voffB); PG8_STAGE(PG8_SA(0, 0), a2, voffA);
            PG8_WAIT_V(8); PG8_WAIT_L(0); PG8_BAR; PG8_MMA(1, 0, At, B0); PG8_MMA(1, 1, At, B1); PG8_BAR; PG8_SCHED;
            PG8_LDB(B0, 1, 0); PG8_LDB(B1, 1, 1); PG8_SCHED; PG8_LDA(At, 1, 0); PG8_STAGE(PG8_SA(0, 1), a2 + hstep, voffA);
            PG8_WAIT_V(8); PG8_WAIT_L(0); PG8_BAR; PG8_MMA(0, 0, At, B0); PG8_MMA(0, 1, At, B1); PG8_BAR; PG8_SCHED;
            PG8_LDA(At, 1, 1); PG8_STAGE(PG8_SB(1, 0), b3, voffB); PG8_STAGE(PG8_SB(1, 1), b3 + hstep, voffB); PG8_STAGE(PG8_SA(1, 0), a3, voffA);
            PG8_WAIT_V(8); PG8_WAIT_L(0); PG8_BAR; PG8_MMA(1, 0, At, B0); PG8_MMA(1, 1, At, B1); PG8_BAR; PG8_SCHED;
            } else {
            PG8_LDB(B0, 0, 0); PG8_SCHED; PG8_LDA(At, 0, 0); PG8_STAGE(PG8_SA(1, 1), a1 + hstep, voffA);
            PG8_WAIT_L(8); PG8_BAR; PG8_WAIT_L(0); PG8_MMA(0, 0, At, B0); PG8_BAR; PG8_SCHED;
            PG8_LDB(B1, 0, 1); PG8_STAGE(PG8_SB(0, 0), b2, voffB);
            PG8_BAR; PG8_WAIT_L(0); PG8_MMA(0, 1, At, B1); PG8_BAR;
            PG8_LDA(At, 0, 1); PG8_STAGE(PG8_SA(0, 0), a2, voffA);
            PG8_BAR; PG8_WAIT_L(0); PG8_MMA(1, 0, At, B0); PG8_BAR; PG8_SCHED;
            PG8_STAGE(PG8_SB(0, 1), b2 + hstep, voffB);
            PG8_WAIT_V(6); PG8_BAR; PG8_MMA(1, 1, At, B1); PG8_BAR;
            PG8_LDB(B0, 1, 0); PG8_SCHED; PG8_LDA(At, 1, 0); PG8_STAGE(PG8_SA(0, 1), a2 + hstep, voffA);
            PG8_WAIT_L(8); PG8_BAR; PG8_WAIT_L(0); PG8_MMA(0, 0, At, B0); PG8_BAR; PG8_SCHED;
            PG8_LDB(B1, 1, 1); PG8_STAGE(PG8_SB(1, 0), b3, voffB);
            PG8_BAR; PG8_WAIT_L(0); PG8_MMA(0, 1, At, B1); PG8_BAR;
            PG8_LDA(At, 1, 1); PG8_STAGE(PG8_SA(1, 0), a3, voffA);
            PG8_BAR; PG8_WAIT_L(0); PG8_MMA(1, 0, At, B0); PG8_BAR; PG8_SCHED;
            PG8_STAGE(PG8_SB(1, 1), b3 + hstep, voffB);
            PG8_WAIT_V(6); PG8_BAR; PG8_MMA(1, 1, At, B1); PG8_BAR;
            }
        }
        if constexpr (ALIGN_EPI) { if (wr == 0) PG8_BAR; }
        if constexpr (!Epi::AFTER_DRAIN) { E(acc, cur, wr, wc, fr, fq); S.done(cur); }
        if (!has_next) break;
#pragma unroll
        for (int a = 0; a < 2; ++a)
#pragma unroll
            for (int b = 0; b < 2; ++b)
#pragma unroll
                for (int m = 0; m < 4; ++m)
#pragma unroll
                    for (int n = 0; n < 2; ++n) acc[a][b][m][n] = (f32x4){0.f, 0.f, 0.f, 0.f};
        cur = nxt; cA = nA; cB = nB; ++ui;
        if constexpr (ALIGN_EPI) { if (wr == 1) PG8_BAR; }
    }
    PG8_WAIT_V(0);
    if constexpr (!ALIGN_EPI) { if (wr == 0) PG8_BAR; }
    PG8_BAR;
    if constexpr (Epi::AFTER_DRAIN) { E.fused(acc, cur, wr, wc, fr, fq, lds, wid, lane); S.done(cur); }
#undef PG8_SA
#undef PG8_SB
#undef PG8_STAGE
#undef PG8_LDA
#undef PG8_LDB
#undef PG8_MMA
#undef PG8_WAIT_V
#undef PG8_WAIT_L
#undef PG8_BAR
#undef PG8_SCHED
}
}
#define GAS __attribute__((address_space(1)))
#define LAS __attribute__((address_space(3)))
typedef unsigned short bf16;
typedef unsigned v4u __attribute__((ext_vector_type(4)));
typedef unsigned v2u __attribute__((ext_vector_type(2)));
typedef float f32x4 __attribute__((ext_vector_type(4)));
typedef short bf16x8 __attribute__((ext_vector_type(8)));
typedef GAS unsigned gu32;
#define RLX_AGENT __ATOMIC_RELAXED, __HIP_MEMORY_SCOPE_AGENT
#define LDS_WAIT() asm volatile("s_waitcnt lgkmcnt(0)" ::: "memory")
#define VM_WAIT() asm volatile("s_waitcnt vmcnt(0)" ::: "memory")

constexpr int NWAVES = 8;
constexpr int TOK = 8192, DM = 2048, DFF = 5632, NLAYER = 4;
constexpr int EIN_SRC = 5200, EIN_NP = 5376, OIN_SRC = 6160, OIN_NP = 6144;
constexpr float EPS = 1e-6f;
constexpr size_t MiB = 1u << 20;
constexpr size_t WS_CTL = 0, CTL_ZERO_BYTES = 1 * MiB;
constexpr size_t WS_MODP = 1 * MiB;
constexpr size_t WS_MODS = 3 * MiB;
constexpr size_t WS_COS = 4 * MiB, WS_SIN = 5 * MiB;
constexpr size_t WS_SSQ = 6 * MiB;
constexpr size_t WS_BA = 6 * MiB + 512 * 1024;
constexpr size_t WS_WGL = 7 * MiB;
constexpr size_t WS_WEIN = 8 * MiB;
constexpr size_t WS_WUQ = WS_WEIN + 42 * MiB;
constexpr size_t WS_WUKV = WS_WUQ + 3 * MiB;
constexpr size_t WS_WEOUT = WS_WUKV + 4 * MiB;
constexpr size_t WS_WOIN = WS_WEOUT + 16 * MiB;
constexpr size_t WS_WOOUT = WS_WOIN + 48 * MiB;
constexpr size_t WS_W13 = WS_WOOUT + 16 * MiB;
constexpr size_t WS_W2 = WS_W13 + 176 * MiB;
constexpr size_t WS_H = WS_W2 + 88 * MiB;
constexpr size_t WS_PROJ = WS_H + 32 * MiB;
constexpr size_t WS_QH = WS_PROJ + 96 * MiB;
constexpr size_t WS_KH = WS_QH + 24 * MiB;
constexpr size_t WS_VT = WS_KH + 24 * MiB;
constexpr size_t WS_MIX = WS_VT + 16 * MiB;
constexpr size_t WS_HID = WS_MIX + 32 * MiB;
constexpr size_t WS_OG = WS_HID + 88 * MiB;
constexpr size_t WS_SCR = WS_OG + 64 * MiB;
constexpr size_t WS_END = WS_SCR + 256 * MiB;
constexpr int CW_BAR = 4096;
constexpr int RING_BYTES = 131072, LDSCTL_OFF = RING_BYTES, LDS_BYTES = 147456, MISC_OFF = LDS_BYTES - 256;

__device__ __forceinline__ unsigned f2bf(float f) { unsigned u = __builtin_bit_cast(unsigned, f); return (u + 0x7fffu + ((u >> 16) & 1u)) >> 16; }
__device__ __forceinline__ unsigned pk2(float lo, float hi) { return f2bf(lo) | (f2bf(hi) << 16); }
__device__ __forceinline__ float bf2f(unsigned b) { return __builtin_bit_cast(float, (b & 0xffffu) << 16); }
__device__ __forceinline__ float bflo(unsigned w) { return __builtin_bit_cast(float, w << 16); }
__device__ __forceinline__ float bfhi(unsigned w) { return __builtin_bit_cast(float, w & 0xffff0000u); }
__device__ __forceinline__ float shx(float v, int k, int lane) { return __builtin_bit_cast(float, __builtin_amdgcn_ds_bpermute((lane ^ k) << 2, __builtin_bit_cast(int, v))); }
__device__ __forceinline__ float wave_sum(float v, int lane) {
#pragma unroll
    for (int o = 1; o < 64; o <<= 1) v += shx(v, o, lane);
    return v;
}
__device__ __forceinline__ float wave_max(float v, int lane) {
#pragma unroll
    for (int o = 1; o < 64; o <<= 1) v = fmaxf(v, shx(v, o, lane));
    return v;
}
__device__ __forceinline__ float silu_f(float a) { return a / (1.0f + __expf(-a)); }
__device__ __forceinline__ float softplus_f(float x) { return x > 20.f ? x : log1pf(__expf(x)); }

__host__ __device__ __forceinline__ int map_ein(int c) { if (c < 1024) return c; if (c < 1088) { const int i = c - 1024; return 5120 + (i < 32 ? 2 * i : 2 * (i - 32) + 1); } if (c < 5184) return c - 64; return c; }
__host__ __device__ __forceinline__ int map_uq(int c) { const int h = c / 192, d = c - h * 192; if (d < 128) return c; const int i = d - 128; return h * 192 + 128 + (i < 32 ? 2 * i : 2 * (i - 32) + 1); }
__host__ __device__ __forceinline__ int map_w13(int hc, int n) { const int pn = hc >> 7, rem = hc & 127, wc = rem >> 5, fq = (rem >> 3) & 3, bj = (rem >> 2) & 1, j = rem & 3; return 256 * pn + 128 * bj + 32 * wc + 8 * fq + 4 * n + j; }
enum { K_PLAIN = 0, K_EIN = 1, K_UQ = 2, K_W1 = 3, K_W3 = 4, K_OIN = 5 };

struct Args { const void* in[25]; float* out; unsigned char* ws; int ph_lo, ph_hi; };
struct Frame {
    LAS unsigned char* lds; unsigned char* ldsg; volatile LAS unsigned* MISC; gu32* ctl; unsigned char* ws;
    int wave, G, gw, NGW;
};
__device__ __forceinline__ int opaque_tid() { int t = threadIdx.x; asm volatile("" : "+v"(t)); return t; }
struct WDesc { const float* W; int ld, ncols, K; const float* kscale; int kind; bf16* D0; bf16* D1; int nitems; };

__device__ __forceinline__ WDesc get_wdesc(const Args& a, int mi) {
    WDesc d; d.kscale = nullptr; d.D1 = nullptr; d.kind = K_PLAIN;
    unsigned char* ws = a.ws;
    if (mi < 8) { const int i = mi >> 2, w = mi & 3;
        if (w == 0) { d.W = (const float*)a.in[6] + (size_t)i * DM * EIN_SRC; d.ld = EIN_SRC; d.ncols = EIN_SRC; d.K = DM; d.kind = K_EIN; d.D0 = (bf16*)(ws + WS_WEIN) + (size_t)i * EIN_NP * DM; }
        else if (w == 1) { d.W = (const float*)a.in[8] + (size_t)i * 512 * 1536; d.ld = 1536; d.ncols = 1536; d.K = 512; d.kind = K_UQ; d.kscale = (const float*)a.in[7] + i * 512; d.D0 = (bf16*)(ws + WS_WUQ) + (size_t)i * 1536 * 512; }
        else if (w == 2) { d.W = (const float*)a.in[10] + (size_t)i * 512 * 2048; d.ld = 2048; d.ncols = 2048; d.K = 512; d.kscale = (const float*)a.in[9] + i * 512; d.D0 = (bf16*)(ws + WS_WUKV) + (size_t)i * 2048 * 512; }
        else { d.W = (const float*)a.in[15] + (size_t)i * DM * DM; d.ld = DM; d.ncols = DM; d.K = DM; d.D0 = (bf16*)(ws + WS_WEOUT) + (size_t)i * DM * DM; }
    } else if (mi < 12) { const int i = (mi - 8) >> 1, w = (mi - 8) & 1;
        if (w == 0) { d.W = (const float*)a.in[16] + (size_t)i * DM * OIN_SRC; d.ld = OIN_SRC; d.ncols = OIN_SRC; d.K = DM; d.kind = K_OIN; d.D0 = (bf16*)(ws + WS_WOIN) + (size_t)i * OIN_NP * DM; d.D1 = (bf16*)(ws + WS_WGL) + (size_t)i * 16 * DM; }
        else { d.W = (const float*)a.in[20] + (size_t)i * DM * DM; d.ld = DM; d.ncols = DM; d.K = DM; d.D0 = (bf16*)(ws + WS_WOOUT) + (size_t)i * DM * DM; }
    } else { const int l = (mi - 12) / 3, w = (mi - 12) - 3 * l;
        if (w == 0) { d.W = (const float*)a.in[21] + (size_t)l * DM * DFF; d.ld = DFF; d.ncols = DFF; d.K = DM; d.kind = K_W1; d.D0 = (bf16*)(ws + WS_W13) + (size_t)l * 2 * DFF * DM; }
        else if (w == 1) { d.W = (const float*)a.in[22] + (size_t)l * DM * DFF; d.ld = DFF; d.ncols = DFF; d.K = DM; d.kind = K_W3; d.D0 = (bf16*)(ws + WS_W13) + (size_t)l * 2 * DFF * DM; }
        else { d.W = (const float*)a.in[23] + (size_t)l * DFF * DM; d.ld = DM; d.ncols = DM; d.K = DFF; d.D0 = (bf16*)(ws + WS_W2) + (size_t)l * DM * DFF; }
    }
    d.nitems = ((d.ncols + 31) / 32) * (d.K / 64);
    return d;
}
__device__ __forceinline__ bf16* wrow_ptr(const WDesc& d, int col) {
    int r = col;
    if (d.kind == K_EIN) r = map_ein(col); else if (d.kind == K_UQ) r = map_uq(col); else if (d.kind == K_W1) r = map_w13(col, 0); else if (d.kind == K_W3) r = map_w13(col, 1);
    else if (d.kind == K_OIN) { if (col >= OIN_NP) return d.D1 + (size_t)(col - OIN_NP) * d.K; }
    return d.D0 + (size_t)r * d.K;
}
__device__ __forceinline__ void p0_item(const WDesc& d, LAS float* scr, int item, int lane) {
    const int ncb = (d.ncols + 31) / 32, kb = item / ncb, cb = item - kb * ncb, k0 = 64 * kb, c0 = 32 * cb;
    const int cc = c0 + (lane & 31); const bool cv = cc < d.ncols;
#pragma unroll 8
    for (int i = 0; i < 32; ++i) { const int kk = 2 * i + (lane >> 5); float v = cv ? d.W[(size_t)(k0 + kk) * d.ld + cc] : 0.f; if (d.kscale) v *= d.kscale[k0 + kk]; scr[kk * 33 + (lane & 31)] = v; }
    LDS_WAIT(); asm volatile("" ::: "memory");
    const int c = lane & 7;
#pragma unroll
    for (int j = 0; j < 4; ++j) { const int n = (lane >> 3) + 8 * j; const int col = c0 + n;
        if (col < d.ncols) { const LAS float* s = scr + (8 * c) * 33 + n;
            v4u o; o.x = pk2(s[0 * 33], s[1 * 33]); o.y = pk2(s[2 * 33], s[3 * 33]); o.z = pk2(s[4 * 33], s[5 * 33]); o.w = pk2(s[6 * 33], s[7 * 33]);
            *(GAS v4u*)(wrow_ptr(d, col) + k0 + 8 * c) = o; } }
    LDS_WAIT(); asm volatile("" ::: "memory");
}
constexpr int ADA_TASKS = 8 * 24 * 8;
__device__ __forceinline__ void p0_prologue(Frame& F, const Args& a) {
    LAS float* scr = (LAS float*)(F.lds + F.wave * 16384);
    const int tid = opaque_tid(), lane = tid & 63;
    int g = F.gw;
    for (; g < ADA_TASKS; g += F.NGW) {
        const int m = g / 192, rem = g - m * 192, cg = rem >> 3, ks = rem & 7;
        const float* W = (const float*)a.in[4] + (size_t)m * DM * 6144 + (size_t)(ks * 256) * 6144 + cg * 256 + 4 * lane;
        const float* cvec = (const float*)a.in[1] + ks * 256;
        f32x4 acc = {0.f, 0.f, 0.f, 0.f};
#pragma unroll 8
        for (int k = 0; k < 256; ++k) { const float cv = cvec[k]; const float sc = cv / (1.0f + __expf(-cv)); const f32x4 w = *(const f32x4*)(W + (size_t)k * 6144); acc += w * sc; }
        *(f32x4*)((float*)(a.ws + WS_MODP) + ((size_t)(m * 8 + ks)) * 6144 + cg * 256 + 4 * lane) = acc;
    }
    g -= ADA_TASKS;
    { int mi = 0, mstart = 0; WDesc d = get_wdesc(a, 0);
      for (;;) { while (mi < 24 && g >= mstart + d.nitems) { mstart += d.nitems; ++mi; if (mi < 24) d = get_wdesc(a, mi); }
          if (mi >= 24) break; p0_item(d, scr, g - mstart, lane); g += F.NGW; } }
    { const size_t per = (size_t)(EIN_NP - EIN_SRC) * DM / 8;
      for (size_t i = (size_t)blockIdx.x * 512 + tid; i < 2 * per; i += (size_t)F.G * 512) { const size_t l = i / per, r = i - l * per;
          *(v4u*)((bf16*)(a.ws + WS_WEIN) + l * EIN_NP * DM + (size_t)EIN_SRC * DM + r * 8) = (v4u){0u, 0u, 0u, 0u}; } }
    { const int* pos = (const int*)a.in[2]; float* ct = (float*)(a.ws + WS_COS); float* st = (float*)(a.ws + WS_SIN);
      for (int i = blockIdx.x * 512 + tid; i < TOK * 32; i += F.G * 512) { const int t = i >> 5, j = i & 31;
          const float inv = powf(10000.0f, -(float)j / 32.0f); const float ang = (float)pos[t] * inv; ct[i] = cosf(ang); st[i] = sinf(ang); } }
}
template <int MODE> __device__ __forceinline__ void norm_phase(Frame& F, const Args& a, const float* xin, const float* g, int modidx, bf16* H, float* outf) {
    float* gs = (float*)F.ldsg; float* sh = gs + 2048;
    const int tid_l = opaque_tid(), lane_l = tid_l & 63;
    for (int c = tid_l; c < 2048; c += 512) {
        const float gv = g[c];
        if (MODE == 0) { const float* bp = (const float*)a.in[5] + (size_t)modidx * 6144; const float* pp = (const float*)(a.ws + WS_MODP) + (size_t)modidx * 8 * 6144;
            float shf = bp[c], scl = bp[2048 + c], gt = bp[4096 + c];
#pragma unroll
            for (int ks = 0; ks < 8; ++ks) { shf += pp[ks * 6144 + c]; scl += pp[ks * 6144 + 2048 + c]; gt += pp[ks * 6144 + 4096 + c]; }
            gs[c] = gv * (1.0f + scl); sh[c] = shf;
            if (blockIdx.x == 0) ((float*)(a.ws + WS_MODS))[modidx * 2048 + c] = gt;
        } else { gs[c] = gv; sh[c] = 0.f; }
    }
    __syncthreads();
    int gw_l = F.gw; asm volatile("" : "+s"(gw_l));
    for (int m = gw_l; m < TOK; m += F.NGW) {
        const f32x4* xr = (const f32x4*)(xin + (size_t)m * DM) + lane_l;
        f32x4 v[8]; float s = 0.f;
#pragma unroll
        for (int j = 0; j < 8; ++j) { v[j] = xr[64 * j]; s += (v[j][0] * v[j][0] + v[j][1] * v[j][1]) + (v[j][2] * v[j][2] + v[j][3] * v[j][3]); }
        const float r = rsqrtf(wave_sum(s, lane_l) * (1.0f / DM) + EPS);
#pragma unroll
        for (int j = 0; j < 8; ++j) { const int col = 4 * lane_l + 256 * j; const f32x4 gg = *(const f32x4*)(gs + col), ss = *(const f32x4*)(sh + col);
            const f32x4 o = v[j] * r * gg + ss;
            if (MODE == 0) { v2u w; w.x = pk2(o[0], o[1]); w.y = pk2(o[2], o[3]); *(v2u*)(H + (size_t)m * DM + col) = w; }
            else *(f32x4*)(outf + (size_t)m * DM + col) = o; }
    }
    __syncthreads();
}
template <int HD> __device__ __forceinline__ void gatenorm_phase(Frame& F, const float* OG, int ogld, const float* gnorm, const bf16* gatein, int gld, bf16* MIX, int mixoff) {
    constexpr int NC = (HD == 128) ? 1024 : 2048, PER = NC / 64, LPH = HD / PER;
    const int lane_l = opaque_tid() & 63; int gw_l = F.gw; asm volatile("" : "+s"(gw_l));
    for (int m = gw_l; m < TOK; m += F.NGW) {
        const float* orow = OG + (size_t)m * ogld + PER * lane_l; float v[PER]; float s = 0.f;
#pragma unroll
        for (int j = 0; j < PER; j += 4) { const f32x4 t = *(const f32x4*)(orow + j); v[j] = t[0]; v[j + 1] = t[1]; v[j + 2] = t[2]; v[j + 3] = t[3]; s += (t[0] * t[0] + t[1] * t[1]) + (t[2] * t[2] + t[3] * t[3]); }
#pragma unroll
        for (int o = 1; o < LPH; o <<= 1) s += shx(s, o, lane_l);
        const float r = rsqrtf(s * (1.0f / HD) + EPS);
        const int cbase = PER * lane_l, hc = cbase % HD;
        const bf16* zr = gatein + (size_t)m * gld + cbase; bf16* out = MIX + (size_t)m * DM + mixoff + cbase;
#pragma unroll
        for (int j = 0; j < PER; j += 8) { const v4u zz = *(const v4u*)(zr + j); float z[8] = {bflo(zz.x), bfhi(zz.x), bflo(zz.y), bfhi(zz.y), bflo(zz.z), bfhi(zz.z), bflo(zz.w), bfhi(zz.w)}; float o8[8];
#pragma unroll
            for (int e = 0; e < 8; ++e) o8[e] = v[j + e] * r * gnorm[hc + j + e] * silu_f(z[e]);
            v4u w; w.x = pk2(o8[0], o8[1]); w.y = pk2(o8[2], o8[3]); w.z = pk2(o8[4], o8[5]); w.w = pk2(o8[6], o8[7]); *(v4u*)(out + j) = w; }
    }
}
#define XB_TMO      128
#define XB_XCNT(j)  (256  + 64 * (j))
#define XB_XSUB(j)  (1280 + 64 * (j))
#define XB_XGEN(j)  (2304 + 64 * (j))
#define XB_TOP      3328
#define XB_TOPGEN   3392
#define XCD_BAR_WORDS 3456
#define XB_SPIN_CAP (1u << 18)

__device__ __forceinline__ unsigned xb_ld(unsigned* p)              { return __hip_atomic_load(p, __ATOMIC_RELAXED, __HIP_MEMORY_SCOPE_AGENT); }
__device__ __forceinline__ unsigned xb_add(unsigned* p, unsigned v) { return __hip_atomic_fetch_add(p, v, __ATOMIC_RELAXED, __HIP_MEMORY_SCOPE_AGENT); }
__device__ __forceinline__ unsigned xb_xcc_id() { return (unsigned)__builtin_amdgcn_s_getreg((3 << 11) | 20) & 0xFu; }
#define XB_SPIN(cond, bar) do { unsigned _sp = 0; while (cond) { __builtin_amdgcn_s_sleep(1); \
    if ((++_sp & 255u) == 0u) { if (xb_ld(&(bar)[XB_TMO])) break; if (_sp > XB_SPIN_CAP) { atomicAdd(&(bar)[XB_TMO], 1u); break; } } } } while (0)

struct XcdBarrier {
    unsigned* bar; unsigned x;
    volatile LAS unsigned* st;
};

__device__ __forceinline__ XcdBarrier xcd_barrier_post(unsigned* bar, volatile LAS unsigned* st) {
    XcdBarrier b; b.bar = bar; b.x = xb_xcc_id(); b.st = st;
    if (threadIdx.x == 0) (void)xb_add(&bar[XB_XCNT(b.x)], 1u);
    return b;
}
__device__ __forceinline__ void xcd_barrier_complete(unsigned* bar, unsigned x, unsigned& nloc, unsigned& nx) {
    const unsigned G = gridDim.x * gridDim.y * gridDim.z;
    unsigned sum, cnt, mine, sp = 0u;
    for (;;) {
        sum = 0u; cnt = 0u; mine = 0u;
#pragma unroll
        for (unsigned j = 0; j < 16; ++j) { const unsigned c = xb_ld(&bar[XB_XCNT(j)]); sum += c; cnt += (c > 0u) ? 1u : 0u; mine = (j == x) ? c : mine; }
        if (sum == G) break;
        __builtin_amdgcn_s_sleep(1);
        if ((++sp & 255u) == 0u) { if (xb_ld(&bar[XB_TMO])) break; if (sp > XB_SPIN_CAP) { atomicAdd(&bar[XB_TMO], 1u); break; } }
    }
    nloc = mine > 0u ? mine : 1u; nx = cnt > 0u ? cnt : 1u;
}

__device__ __forceinline__ void xcd_barrier(const XcdBarrier& b) {
    asm volatile("s_waitcnt vmcnt(0)" ::: "memory");
    __syncthreads();
    if (threadIdx.x == 0) {
        unsigned* bar = b.bar;
        __builtin_amdgcn_s_waitcnt(0);
        unsigned nloc = b.st[0], nx = b.st[1];
        if (nloc == 0u) { xcd_barrier_complete(bar, b.x, nloc, nx); b.st[0] = nloc; b.st[1] = nx; }
        const unsigned old = xb_add(&bar[XB_XSUB(b.x)], 1u);
        const unsigned gen = old / nloc;
        if (old + 1u == (gen + 1u) * nloc) {
            __builtin_amdgcn_fence(__ATOMIC_RELEASE, "agent");
            asm volatile("s_waitcnt vmcnt(0)" ::: "memory");
            const unsigned og = xb_add(&bar[XB_TOP], 1u);
            const unsigned tg = og / nx;
            if (og + 1u == (tg + 1u) * nx) xb_add(&bar[XB_TOPGEN], 1u);
            else XB_SPIN(xb_ld(&bar[XB_TOPGEN]) == tg, bar);
            __builtin_amdgcn_fence(__ATOMIC_ACQUIRE, "agent");
            xb_add(&bar[XB_XGEN(b.x)], 1u);
            asm volatile("s_waitcnt vmcnt(0)" ::: "memory");
        } else {
            XB_SPIN(xb_ld(&bar[XB_XGEN(b.x)]) == gen, bar);
            __builtin_amdgcn_fence(__ATOMIC_ACQUIRE, "agent");
            asm volatile("s_waitcnt vmcnt(0)" ::: "memory");
        }
    }
    __syncthreads();
}
typedef float f32x16 __attribute__((ext_vector_type(16)));
constexpr int AT_TILES_HEAD = 2112, AT_TILES = 8 * AT_TILES_HEAD;
constexpr int AT_KSTR = 400, AT_VSTR = 136;
constexpr int AT_KBYTES = 64 * AT_KSTR, AT_VBYTES = 128 * AT_VSTR, AT_BUF = AT_KBYTES + AT_VBYTES;
constexpr size_t AT_OPART_BYTES = (size_t)256 * 3 * 256 * 128 * 4;
__device__ __forceinline__ int at_start(int c, int nb) { return (int)(((long)c * AT_TILES) / nb); }
__device__ __forceinline__ void at_decode(int s, int& h, int& i, int& j) {
    h = s / AT_TILES_HEAD; const int r = s - h * AT_TILES_HEAD;
    int ii = (int)((sqrtf(1.0f + 2.0f * (float)r) - 1.0f) * 0.5f);
    if (ii < 0) ii = 0; if (ii > 31) ii = 31;
    while (ii < 31 && 2 * (ii + 1) * (ii + 2) <= r) ++ii;
    while (ii > 0 && 2 * ii * (ii + 1) > r) --ii;
    i = ii; j = r - 2 * ii * (ii + 1);
}
__device__ __forceinline__ int at_owner(int s, int nb) {
    int c = (int)(((long)s * nb) / AT_TILES);
    while (c + 1 < nb && at_start(c + 1, nb) <= s) ++c;
    while (c > 0 && at_start(c, nb) > s) --c;
    return c;
}
__device__ __forceinline__ float fexp2(float x) { return __builtin_amdgcn_exp2f(x); }
__device__ __forceinline__ unsigned cvtpk(float lo, float hi) { unsigned r; asm volatile("v_cvt_pk_bf16_f32 %0, %1, %2" : "=v"(r) : "v"(lo), "v"(hi)); return r; }

__device__ __forceinline__ void attn_phase(Frame& F, const bf16* QH, const bf16* KH, const bf16* VT, bf16* MIX, float* OPART, float* ML, int vcu, int b0) {
    const int nb = F.G - b0, c = vcu - b0;
    if (c < 0) return;
    const int tid = opaque_tid(), lane = tid & 63, w = F.wave, r = lane & 31, hh = lane >> 5;
    LAS unsigned char* lds = F.lds;
    const int kkey = tid >> 3, kc8 = tid & 7, vdv = tid >> 2, vc4 = tid & 3;
    const unsigned lK = (unsigned)(kkey * AT_KSTR + kc8 * 16), lV = (unsigned)(AT_KBYTES + vdv * AT_VSTR + vc4 * 16);
    const unsigned aK = (unsigned)(r * AT_KSTR + hh * 16), aV = (unsigned)(AT_KBYTES + r * AT_VSTR + hh * 8);
    int cur = at_start(c, nb); const int end = at_start(c + 1, nb);
    while (cur < end) {
        int h, i, j0; at_decode(cur, h, i, j0);
        const int n_i = 4 * (i + 1), j1 = (j0 + (end - cur) < n_i) ? j0 + (end - cur) : n_i, base = cur - j0;
        const bool whole = (j0 == 0) && (j1 == n_i);
        const int part = c - at_owner(base, nb);
        cur += j1 - j0;
        const int qrow = 256 * i + 32 * w + r;
        bf16x8 qf[12];
        { const bf16* qp = QH + ((size_t)h * TOK + qrow) * 192 + 8 * hh;
#pragma unroll
          for (int s = 0; s < 12; ++s) qf[s] = *(const bf16x8*)(qp + 16 * s); }
        f32x16 o[4];
#pragma unroll
        for (int d = 0; d < 4; ++d)
#pragma unroll
            for (int e = 0; e < 16; ++e) o[d][e] = 0.f;
        float m = -1e30f, l = 0.f;
        const bf16* gK = KH + ((size_t)h * TOK + kkey) * 192 + 8 * kc8;
        const bf16* gV = VT + ((size_t)h * 128 + vdv) * TOK + 8 * vc4;
        v4u kreg[3], vreg[2];
#define AT_LOAD(j) do { const bf16* pk_ = gK + (size_t)(j) * (64 * 192); const bf16* pv_ = gV + (size_t)(j) * 64; \
        kreg[0] = *(const v4u*)(pk_); kreg[1] = *(const v4u*)(pk_ + 64); kreg[2] = *(const v4u*)(pk_ + 128); vreg[0] = *(const v4u*)(pv_); vreg[1] = *(const v4u*)(pv_ + 32); } while (0)
#define AT_STORE(buf) do { LAS unsigned char* b_ = lds + (buf) * AT_BUF; \
        *(LAS v4u*)(b_ + lK) = kreg[0]; *(LAS v4u*)(b_ + lK + 128) = kreg[1]; *(LAS v4u*)(b_ + lK + 256) = kreg[2]; \
        *(LAS v2u*)(b_ + lV) = (v2u){vreg[0].x, vreg[0].y}; *(LAS v2u*)(b_ + lV + 8) = (v2u){vreg[0].z, vreg[0].w}; \
        *(LAS v2u*)(b_ + lV + 64) = (v2u){vreg[1].x, vreg[1].y}; *(LAS v2u*)(b_ + lV + 72) = (v2u){vreg[1].z, vreg[1].w}; } while (0)
        __syncthreads();
        AT_LOAD(j0); AT_STORE(0);
        __syncthreads();
        int cb = 0;
        for (int j = j0; j < j1; ++j) {
            if (j + 1 < j1) AT_LOAD(j + 1);
            const bool diag = (j >= 4 * i);
            if (!(diag && 64 * j > 256 * i + 32 * w + 31)) {
                LAS unsigned char* kb = lds + cb * AT_BUF;
                f32x16 s0, s1;
#pragma unroll
                for (int e = 0; e < 16; ++e) { s0[e] = 0.f; s1[e] = 0.f; }
#pragma unroll
                for (int s = 0; s < 12; ++s) {
                    const bf16x8 a0 = *(const LAS bf16x8*)(kb + aK + s * 32), a1 = *(const LAS bf16x8*)(kb + aK + 32 * AT_KSTR + s * 32);
                    s0 = __builtin_amdgcn_mfma_f32_32x32x16_bf16(a0, qf[s], s0, 0, 0, 0);
                    s1 = __builtin_amdgcn_mfma_f32_32x32x16_bf16(a1, qf[s], s1, 0, 0, 0);
                }
                if (diag) {
                    const int kq = 64 * j + 4 * hh - qrow;
#pragma unroll
                    for (int e = 0; e < 16; ++e) { const int ko = (e & 3) + 8 * (e >> 2);
                        if (kq + ko > 0) s0[e] = -INFINITY; if (kq + ko + 32 > 0) s1[e] = -INFINITY; }
                }
                float mx = fmaxf(s0[0], s1[0]);
#pragma unroll
                for (int e = 1; e < 16; ++e) mx = fmaxf(mx, fmaxf(s0[e], s1[e]));
                mx = fmaxf(mx, shx(mx, 32, lane));
                const float mn = fmaxf(m, mx), alpha = fexp2(m - mn); m = mn;
                float ps = 0.f;
#pragma unroll
                for (int e = 0; e < 16; ++e) { s0[e] = fexp2(s0[e] - mn); s1[e] = fexp2(s1[e] - mn); ps += s0[e] + s1[e]; }
                l = l * alpha + ps;
#pragma unroll
                for (int d = 0; d < 4; ++d)
#pragma unroll
                    for (int e = 0; e < 16; ++e) o[d][e] *= alpha;
                bf16x8 pf[4];
                { v4u t;
                  t.x = cvtpk(s0[0], s0[1]); t.y = cvtpk(s0[2], s0[3]); t.z = cvtpk(s0[4], s0[5]); t.w = cvtpk(s0[6], s0[7]); pf[0] = __builtin_bit_cast(bf16x8, t);
                  t.x = cvtpk(s0[8], s0[9]); t.y = cvtpk(s0[10], s0[11]); t.z = cvtpk(s0[12], s0[13]); t.w = cvtpk(s0[14], s0[15]); pf[1] = __builtin_bit_cast(bf16x8, t);
                  t.x = cvtpk(s1[0], s1[1]); t.y = cvtpk(s1[2], s1[3]); t.z = cvtpk(s1[4], s1[5]); t.w = cvtpk(s1[6], s1[7]); pf[2] = __builtin_bit_cast(bf16x8, t);
                  t.x = cvtpk(s1[8], s1[9]); t.y = cvtpk(s1[10], s1[11]); t.z = cvtpk(s1[12], s1[13]); t.w = cvtpk(s1[14], s1[15]); pf[3] = __builtin_bit_cast(bf16x8, t); }
#pragma unroll
                for (int d = 0; d < 4; ++d)
#pragma unroll
                    for (int ks = 0; ks < 4; ++ks) {
                        const v2u lo = *(const LAS v2u*)(kb + aV + d * 32 * AT_VSTR + ks * 32), hi = *(const LAS v2u*)(kb + aV + d * 32 * AT_VSTR + ks * 32 + 16);
                        const v4u av = {lo.x, lo.y, hi.x, hi.y};
                        o[d] = __builtin_amdgcn_mfma_f32_32x32x16_bf16(__builtin_bit_cast(bf16x8, av), pf[ks], o[d], 0, 0, 0);
                    }
            }
            if (j + 1 < j1) AT_STORE(cb ^ 1);
            __syncthreads();
            cb ^= 1;
        }
#undef AT_LOAD
#undef AT_STORE
        const float lt = l + shx(l, 32, lane);
        if (whole) {
            const float inv = 1.0f / lt;
            bf16* op = MIX + (size_t)qrow * DM + h * 128 + 4 * hh;
#pragma unroll
            for (int d = 0; d < 4; ++d)
#pragma unroll
                for (int g4 = 0; g4 < 4; ++g4) { v2u wv; wv.x = pk2(o[d][4 * g4] * inv, o[d][4 * g4 + 1] * inv); wv.y = pk2(o[d][4 * g4 + 2] * inv, o[d][4 * g4 + 3] * inv);
                    *(v2u*)(op + 32 * d + 8 * g4) = wv; }
        } else {
            const size_t slot = (size_t)(h * 32 + i) * 3 + part;
            float* op = OPART + (slot * 256 + 32 * w + r) * 128 + 4 * hh;
#pragma unroll
            for (int d = 0; d < 4; ++d)
#pragma unroll
                for (int g4 = 0; g4 < 4; ++g4) *(f32x4*)(op + 32 * d + 8 * g4) = (f32x4){o[d][4 * g4], o[d][4 * g4 + 1], o[d][4 * g4 + 2], o[d][4 * g4 + 3]};
            if (hh == 0) { float* mp = ML + (slot * 256 + 32 * w + r) * 2; mp[0] = m; mp[1] = lt; }
        }
    }
    __syncthreads();
}
__device__ __forceinline__ void attn_merge_phase(Frame& F, const float* OPART, const float* ML, bf16* MIX, int b0) {
    const int nb = F.G - b0, lane = opaque_tid() & 63;
    int gw_l = F.gw; asm volatile("" : "+s"(gw_l));
    for (int task = gw_l; task < 256 * 256; task += F.NGW) {
        const int b = task >> 8, row = task & 255, h = b >> 5, i = b & 31;
        const int base = h * AT_TILES_HEAD + 2 * i * (i + 1), n_i = 4 * (i + 1);
        const int clo = at_owner(base, nb), chi = at_owner(base + n_i - 1, nb), np = chi - clo + 1;
        if (np <= 1) continue;
        float mk[3], lk[3]; float M = -1e30f;
#pragma unroll
        for (int k = 0; k < 3; ++k) { mk[k] = -1e30f; lk[k] = 0.f; if (k < np) { const float* mp = ML + (((size_t)b * 3 + k) * 256 + row) * 2; mk[k] = mp[0]; lk[k] = mp[1]; } M = fmaxf(M, mk[k]); }
        float L = 0.f, o0 = 0.f, o1 = 0.f;
#pragma unroll
        for (int k = 0; k < 3; ++k) if (k < np) { const float wk = fexp2(mk[k] - M); L += wk * lk[k]; const float* op = OPART + (((size_t)b * 3 + k) * 256 + row) * 128 + 2 * lane; o0 += wk * op[0]; o1 += wk * op[1]; }
        const float inv = 1.0f / L;
        *(unsigned*)(MIX + (size_t)(256 * i + row) * DM + h * 128 + 2 * lane) = pk2(o0 * inv, o1 * inv);
    }
}
constexpr int GD_WP = 0, GD_QD = 16384, GD_AI = 32768, GD_KDT = 40960, GD_U = 57344, GD_EGL = 90112, GD_UNIT = 90368;
constexpr size_t GD_OPS_BYTES = (size_t)1024 * GD_UNIT;
__host__ __device__ __forceinline__ int perm_pos(int o) { return (o < 16) ? 8 * (o >> 2) + (o & 3) : 8 * ((o - 16) >> 2) + 4 + (o & 3); }
constexpr int GP_XF = 0, GP_KF = 32768, GP_VF = 65536, GP_QB = 98304, GP_KB = 115712, GP_G = 133120;
constexpr int GP_BSTR = 272, GP_LSTR = 68;
typedef float f32x4v __attribute__((ext_vector_type(4)));

__device__ __forceinline__ void gdn_prep_phase(Frame& F, const bf16* QKV, const float* BA, const float* convw, const float* a_log, const float* dt_bias, unsigned char* OPS) {
    const int tid = opaque_tid(), lane = tid & 63, w = F.wave;
    LAS unsigned char* lds = F.lds;
    LAS float* XF = (LAS float*)(lds + GP_XF); LAS float* KF = (LAS float*)(lds + GP_KF); LAS float* VF = (LAS float*)(lds + GP_VF);
    LAS float* LM = (LAS float*)(lds + GP_XF);
    LAS float* gbeta = (LAS float*)(lds + GP_G); LAS float* ggc = gbeta + 64; LAS float* gegc = gbeta + 128;
    for (int unit = blockIdx.x; unit < 1024; unit += F.G) {
        const int h = unit & 7, n = unit >> 3, t0 = 64 * n;
        unsigned char* ops = OPS + (size_t)(h * 128 + n) * GD_UNIT;
        if (tid < 384) {
            const int seg = tid >> 7, rh = (tid >> 6) & 1, cp = tid & 63, ch = seg * 1024 + h * 128 + 2 * cp;
            float w0[4], w1[4];
#pragma unroll
            for (int j = 0; j < 4; ++j) { w0[j] = convw[j * 3072 + ch]; w1[j] = convw[j * 3072 + ch + 1]; }
            float a0[3], a1[3];
#pragma unroll
            for (int j = 0; j < 3; ++j) { const int tt = t0 + 32 * rh - 3 + j; unsigned v = 0u; if (tt >= 0) v = *(const unsigned*)(QKV + (size_t)tt * 3072 + ch); a0[j] = bflo(v); a1[j] = bfhi(v); }
            LAS float* dst = (seg == 0 ? XF : seg == 1 ? KF : VF) + 2 * cp;
#pragma unroll 4
            for (int t = 0; t < 32; ++t) { const int tt = t0 + 32 * rh + t; const unsigned v = *(const unsigned*)(QKV + (size_t)tt * 3072 + ch); const float c0 = bflo(v), c1 = bfhi(v);
                const float y0 = w0[0] * a0[0] + w0[1] * a0[1] + w0[2] * a0[2] + w0[3] * c0, y1 = w1[0] * a1[0] + w1[1] * a1[1] + w1[2] * a1[2] + w1[3] * c1;
                a0[0] = a0[1]; a0[1] = a0[2]; a0[2] = c0; a1[0] = a1[1]; a1[1] = a1[2]; a1[2] = c1;
                dst[(32 * rh + t) * 128] = silu_f(y0); dst[(32 * rh + t) * 128 + 1] = silu_f(y1); }
        }
        __syncthreads();
        for (int rr = 0; rr < 16; ++rr) { const int row = w * 16 + rr;
            const bool isk = row >= 64; const int t = row & 63; LAS float* src = (isk ? KF : XF) + t * 128 + 2 * lane;
            const float v0 = src[0], v1 = src[1]; const float rn = rsqrtf(wave_sum(v0 * v0 + v1 * v1, lane) + EPS);
            if (isk) { src[0] = v0 * rn; src[1] = v1 * rn; *(LAS unsigned*)(lds + GP_KB + t * GP_BSTR + 4 * lane) = pk2(v0 * rn, v1 * rn); }
            else *(LAS unsigned*)(lds + GP_QB + t * GP_BSTR + 4 * lane) = pk2(v0 * rn * 0.08838834764831845f, v1 * rn * 0.08838834764831845f); }
        if (w == 0) {
            const float beta = 1.0f / (1.0f + __expf(-BA[(size_t)(t0 + lane) * 16 + h]));
            const float g = -__expf(a_log[h]) * softplus_f(BA[(size_t)(t0 + lane) * 16 + 8 + h] + dt_bias[h]);
            float gc = g;
#pragma unroll
            for (int d = 1; d < 64; d <<= 1) { const float up = __builtin_bit_cast(float, __builtin_amdgcn_ds_bpermute(((lane - d) & 63) << 2, __builtin_bit_cast(int, gc))); if (lane >= d) gc += up; }
            gbeta[lane] = beta; ggc[lane] = gc; gegc[lane] = __expf(gc); gbeta[192 + lane] = beta * __expf(gc);
        }
        __syncthreads();
        {   const int fr = lane & 15, fg = lane >> 4;
#pragma unroll 1
            for (int tt = 0; tt < 4; ++tt) { const int task = w * 4 + tt, isA = task >> 4, mi = (task >> 2) & 3, nj = task & 3;
                if (mi >= nj) {
                    f32x4v acc = {0.f, 0.f, 0.f, 0.f};
                    const LAS unsigned char* ab = lds + (isA ? GP_QB : GP_KB) + (16 * mi + fr) * GP_BSTR + 16 * fg; const LAS unsigned char* bb = lds + GP_KB + (16 * nj + fr) * GP_BSTR + 16 * fg;
#pragma unroll
                    for (int s = 0; s < 4; ++s) acc = __builtin_amdgcn_mfma_f32_16x16x32_bf16(*(const LAS bf16x8*)(ab + 64 * s), *(const LAS bf16x8*)(bb + 64 * s), acc, 0, 0, 0);
                    const int j = 16 * nj + fr; const float gj = ggc[j];
#pragma unroll
                    for (int e = 0; e < 4; ++e) { const int i = 16 * mi + 4 * fg + e; const float dec = __expf(ggc[i] - gj);
                        if (isA) { const float v = (i >= j) ? acc[e] * dec : 0.f; *(bf16*)(ops + GD_AI + i * 128 + ((j & 32) + perm_pos(j & 31)) * 2) = (bf16)f2bf(v); }
                        else { LM[i * GP_LSTR + j] = (i > j) ? acc[e] * dec * gbeta[i] : 0.f; } }
                } else if (isA) {
                    const int j = 16 * nj + fr;
#pragma unroll
                    for (int e = 0; e < 4; ++e) { const int i = 16 * mi + 4 * fg + e; *(bf16*)(ops + GD_AI + i * 128 + ((j & 32) + perm_pos(j & 31)) * 2) = (bf16)0; }
                }
            }
        }
        __syncthreads();
        if (tid < 256) {
            const int c = tid, isw = c >> 7, cc = c & 127;
            const LAS float* bsrc = (isw ? KF : VF) + cc; const LAS float* facp = gbeta + (isw ? 192 : 0);
            float x[64];
#pragma unroll
            for (int i = 0; i < 64; ++i) x[i] = 0.f;
#pragma unroll
            for (int i = 0; i < 64; ++i) {
                float acc = bsrc[i * 128] * facp[i];
#pragma unroll
                for (int j4 = 0; j4 < 16; ++j4) if (4 * j4 < i) { const f32x4v l4 = *(const LAS f32x4v*)(LM + i * GP_LSTR + 4 * j4);
                    acc -= l4[0] * x[4 * j4]; acc -= l4[1] * x[4 * j4 + 1]; acc -= l4[2] * x[4 * j4 + 2]; acc -= l4[3] * x[4 * j4 + 3]; }
                x[i] = acc;
                __builtin_amdgcn_sched_barrier(0);
            }
            if (isw) {
                bf16* wp = (bf16*)(ops + GD_WP) + (cc & 96) + perm_pos(cc & 31);
#pragma unroll
                for (int i = 0; i < 64; ++i) wp[i * 128] = (bf16)f2bf(x[i]);
            } else {
                float* up = (float*)(ops + GD_U) + (size_t)(cc >> 4) * 1024 + (cc & 15) * 4;
#pragma unroll
                for (int i = 0; i < 64; ++i) up[(i >> 4) * 256 + ((i & 15) >> 2) * 64 + (i & 3)] = x[i];
            }
        } else {
            const int u2 = tid - 256;
            { const int t = u2 >> 2, db = u2 & 3; const float eg = gegc[t]; const LAS unsigned* qs = (const LAS unsigned*)(lds + GP_QB + t * GP_BSTR + 64 * db);
              float v[32];
#pragma unroll
              for (int e = 0; e < 16; ++e) { const unsigned wv = qs[e]; v[2 * e] = bflo(wv) * eg; v[2 * e + 1] = bfhi(wv) * eg; }
              v4u o4[4];
#pragma unroll
              for (int g = 0; g < 4; ++g) { o4[g].x = pk2(v[4 * g], v[4 * g + 1]); o4[g].y = pk2(v[4 * g + 2], v[4 * g + 3]); o4[g].z = pk2(v[16 + 4 * g], v[16 + 4 * g + 1]); o4[g].w = pk2(v[16 + 4 * g + 2], v[16 + 4 * g + 3]); }
              v4u* dst = (v4u*)(ops + GD_QD + t * 256 + 64 * db);
#pragma unroll
              for (int g = 0; g < 4; ++g) dst[g] = o4[g]; }
            { const int d = u2 >> 1, tb = u2 & 1; const float gl = ggc[63];
              float v[32];
#pragma unroll
              for (int e = 0; e < 32; ++e) { const int t = 32 * tb + e; v[e] = KF[t * 128 + d] * __expf(gl - ggc[t]); }
              v4u* dst = (v4u*)(ops + GD_KDT + d * 128 + 64 * tb);
#pragma unroll
              for (int g = 0; g < 4; ++g) { v4u o4; o4.x = pk2(v[4 * g], v[4 * g + 1]); o4.y = pk2(v[4 * g + 2], v[4 * g + 3]); o4.z = pk2(v[16 + 4 * g], v[16 + 4 * g + 1]); o4.w = pk2(v[16 + 4 * g + 2], v[16 + 4 * g + 3]); dst[g] = o4; } }
            if (u2 == 0) *(float*)(ops + GD_EGL) = gegc[63];
        }
        __syncthreads();
    }
}

constexpr int GS_WP = 0, GS_QD = 17408, GS_AI = 34816, GS_KDT = 44032, GS_BUF = 62464, GS_PART = 2 * GS_BUF;
__device__ __forceinline__ void gdn_scan_phase(Frame& F, const unsigned char* OPS, const bf16* Z, const float* gnorm, bf16* MIX, int h) {
    const int tid = opaque_tid(), lane = tid & 63, w = F.wave, fr = lane & 15, fg = lane >> 4;
    LAS unsigned char* lds = F.lds;
    const unsigned gofA = (unsigned)tid * 16u, lofA = (unsigned)((tid >> 4) * 272 + (tid & 15) * 16), lofB = (unsigned)((tid >> 3) * 144 + (tid & 7) * 16);
    f32x4v Sf[8];
#pragma unroll
    for (int t = 0; t < 8; ++t) Sf[t] = (f32x4v){0.f, 0.f, 0.f, 0.f};
    v4u pre[7]; f32x4v upre[4]; float eglp;
#define GS_LOAD(n) do { const unsigned char* o_ = OPS + (size_t)(h * 128 + (n)) * GD_UNIT; \
        pre[0] = *(const v4u*)(o_ + GD_WP + gofA); pre[1] = *(const v4u*)(o_ + GD_WP + gofA + 8192); pre[2] = *(const v4u*)(o_ + GD_QD + gofA); pre[3] = *(const v4u*)(o_ + GD_QD + gofA + 8192); \
        pre[4] = *(const v4u*)(o_ + GD_AI + gofA); pre[5] = *(const v4u*)(o_ + GD_KDT + gofA); pre[6] = *(const v4u*)(o_ + GD_KDT + gofA + 8192); \
        _Pragma("unroll") for (int m_ = 0; m_ < 4; ++m_) upre[m_] = *(const f32x4v*)(o_ + GD_U + ((size_t)(w * 4 + m_) * 64 + lane) * 16); eglp = *(const float*)(o_ + GD_EGL); } while (0)
#define GS_STORE(buf) do { LAS unsigned char* b_ = lds + (buf) * GS_BUF; \
        *(LAS v4u*)(b_ + GS_WP + lofA) = pre[0]; *(LAS v4u*)(b_ + GS_WP + lofA + 32 * 272) = pre[1]; *(LAS v4u*)(b_ + GS_QD + lofA) = pre[2]; *(LAS v4u*)(b_ + GS_QD + lofA + 32 * 272) = pre[3]; \
        *(LAS v4u*)(b_ + GS_AI + lofB) = pre[4]; *(LAS v4u*)(b_ + GS_KDT + lofB) = pre[5]; *(LAS v4u*)(b_ + GS_KDT + lofB + 64 * 144) = pre[6]; } while (0)
    GS_LOAD(0); GS_STORE(0);
    f32x4v ucur[4]; float egl = eglp;
#pragma unroll
    for (int m = 0; m < 4; ++m) ucur[m] = upre[m];
    __syncthreads();
    const unsigned aA = (unsigned)(fr * 272 + fg * 16), aB = (unsigned)(fr * 144 + fg * 16);
    const float gn = gnorm[16 * w + fr];
    int cb = 0;
    for (int n = 0; n < 128; ++n) {
        if (n + 1 < 128) GS_LOAD(n + 1);
        LAS unsigned char* b = lds + cb * GS_BUF;
        bf16x8 Sb[4];
#pragma unroll
        for (int s = 0; s < 4; ++s) { v4u t; t.x = cvtpk(Sf[2 * s][0], Sf[2 * s][1]); t.y = cvtpk(Sf[2 * s][2], Sf[2 * s][3]); t.z = cvtpk(Sf[2 * s + 1][0], Sf[2 * s + 1][1]); t.w = cvtpk(Sf[2 * s + 1][2], Sf[2 * s + 1][3]); Sb[s] = __builtin_bit_cast(bf16x8, t); }
        f32x4v vn[4], oo[4];
#pragma unroll
        for (int m = 0; m < 4; ++m) { f32x4v a1 = {0.f, 0.f, 0.f, 0.f}, a2 = {0.f, 0.f, 0.f, 0.f};
#pragma unroll
            for (int s = 0; s < 4; ++s) { a1 = __builtin_amdgcn_mfma_f32_16x16x32_bf16(*(const LAS bf16x8*)(b + GS_WP + aA + m * 16 * 272 + s * 64), Sb[s], a1, 0, 0, 0);
                                          a2 = __builtin_amdgcn_mfma_f32_16x16x32_bf16(*(const LAS bf16x8*)(b + GS_QD + aA + m * 16 * 272 + s * 64), Sb[s], a2, 0, 0, 0); }
            vn[m] = ucur[m] - a1; oo[m] = a2; }
        bf16x8 Vb[2];
#pragma unroll
        for (int s = 0; s < 2; ++s) { v4u t; t.x = cvtpk(vn[2 * s][0], vn[2 * s][1]); t.y = cvtpk(vn[2 * s][2], vn[2 * s][3]); t.z = cvtpk(vn[2 * s + 1][0], vn[2 * s + 1][1]); t.w = cvtpk(vn[2 * s + 1][2], vn[2 * s + 1][3]); Vb[s] = __builtin_bit_cast(bf16x8, t); }
#pragma unroll
        for (int m = 0; m < 4; ++m)
#pragma unroll
            for (int s = 0; s < 2; ++s) oo[m] = __builtin_amdgcn_mfma_f32_16x16x32_bf16(*(const LAS bf16x8*)(b + GS_AI + aB + m * 16 * 144 + s * 64), Vb[s], oo[m], 0, 0, 0);
#pragma unroll
        for (int t = 0; t < 8; ++t) { f32x4v a = Sf[t] * egl;
#pragma unroll
            for (int s = 0; s < 2; ++s) a = __builtin_amdgcn_mfma_f32_16x16x32_bf16(*(const LAS bf16x8*)(b + GS_KDT + aB + t * 16 * 144 + s * 64), Vb[s], a, 0, 0, 0);
            Sf[t] = a; }
        LAS float* part = (LAS float*)(lds + GS_PART + (n & 1) * 2048);
#pragma unroll
        for (int m = 0; m < 4; ++m)
#pragma unroll
            for (int e = 0; e < 4; ++e) { float q = oo[m][e] * oo[m][e]; q += shx(q, 1, lane); q += shx(q, 2, lane); q += shx(q, 4, lane); q += shx(q, 8, lane); if (fr == 0) part[(16 * m + 4 * fg + e) * 8 + w] = q; }
        if (n + 1 < 128) GS_STORE(cb ^ 1);
        __syncthreads();
#pragma unroll
        for (int m = 0; m < 4; ++m)
#pragma unroll
            for (int e = 0; e < 4; ++e) { const int t = 16 * m + 4 * fg + e; const f32x4v p0 = *(const LAS f32x4v*)(part + t * 8), p1 = *(const LAS f32x4v*)(part + t * 8 + 4);
                const float tot = ((p0[0] + p0[1]) + (p0[2] + p0[3])) + ((p1[0] + p1[1]) + (p1[2] + p1[3])); const float rn = rsqrtf(tot * (1.0f / 128.0f) + EPS);
                const size_t row = (size_t)(64 * n + t); const float z = bf2f(Z[row * 1024 + h * 128 + 16 * w + fr]);
                MIX[row * DM + 1024 + h * 128 + 16 * w + fr] = (bf16)f2bf(oo[m][e] * rn * gn * silu_f(z)); }
        if (n + 1 < 128) {
#pragma unroll
            for (int m = 0; m < 4; ++m) ucur[m] = upre[m];
            egl = eglp; }
        cb ^= 1;
    }
#undef GS_LOAD
#undef GS_STORE
    __syncthreads();
}
constexpr int GL_QP = 0, GL_AI = 32768, GL_KDT = 40960, GL_VT = 73728, GL_DL = 139264, GL_UNIT = 140288;
constexpr size_t GL_OPS_BYTES = (size_t)512 * GL_UNIT;
constexpr int GLP_GKL = 0, GLP_BC = 8192, GLP_QPB = 73728, GLP_KPB = 107520, GLP_STR = 528;
constexpr int NGRP = 16, GCH = 8;

__device__ __forceinline__ void gla_prep_phase(Frame& F, const bf16* H, const bf16* WGL, const float* w2, const float* b2, const bf16* GQ, const bf16* GK, const bf16* GV, unsigned char* OPS) {
    const int tid = opaque_tid(), lane = tid & 63, w = F.wave, fr = lane & 15, fg = lane >> 4;
    LAS unsigned char* lds = F.lds;
    LAS float* GKL = (LAS float*)(lds + GLP_GKL); LAS float* BC = (LAS float*)(lds + GLP_BC);
    for (int unit = blockIdx.x; unit < 512; unit += F.G) {
        const int h = unit & 3, n = unit >> 2, t0 = 64 * n;
        unsigned char* ops = OPS + (size_t)(h * 128 + n) * GL_UNIT;
        { const int m = w & 3, kh = w >> 2; f32x4v acc = {0.f, 0.f, 0.f, 0.f};
          const bf16* ap = H + (size_t)(t0 + 16 * m + fr) * DM + 1024 * kh + 8 * fg; const bf16* bp = WGL + (size_t)fr * DM + 1024 * kh + 8 * fg;
#pragma unroll 8
          for (int s = 0; s < 32; ++s) acc = __builtin_amdgcn_mfma_f32_16x16x32_bf16(*(const bf16x8*)(ap + 32 * s), *(const bf16x8*)(bp + 32 * s), acc, 0, 0, 0);
#pragma unroll
          for (int e = 0; e < 4; ++e) GKL[kh * 1024 + (16 * m + 4 * fg + e) * 16 + fr] = acc[e]; }
        __syncthreads();
        if (tid < 256) {
            const int c = tid; float wr[16];
#pragma unroll
            for (int r = 0; r < 16; ++r) wr[r] = w2[r * 1024 + h * 256 + c];
            const float bb = b2[h * 256 + c]; float bc = 0.f;
#pragma unroll 2
            for (int t = 0; t < 64; ++t) { float z = bb;
#pragma unroll
                for (int r4 = 0; r4 < 4; ++r4) { const f32x4v a0 = *(const LAS f32x4v*)(GKL + t * 16 + 4 * r4), a1 = *(const LAS f32x4v*)(GKL + 1024 + t * 16 + 4 * r4);
                    z += (a0[0] + a1[0]) * wr[4 * r4] + (a0[1] + a1[1]) * wr[4 * r4 + 1] + (a0[2] + a1[2]) * wr[4 * r4 + 2] + (a0[3] + a1[3]) * wr[4 * r4 + 3]; }
                bc += -softplus_f(-z) * 0.0625f; BC[t * 256 + c] = bc; }
        } else {
#pragma unroll 1
            for (int cc = 0; cc < 2; ++cc) { const int col = (tid - 256) + 256 * cc; const bf16* vp = GV + (size_t)t0 * 2048 + h * 512 + col; v4u* dst = (v4u*)(ops + GL_VT + col * 128);
#pragma unroll 2
                for (int t8 = 0; t8 < 8; ++t8) { unsigned x[8];
#pragma unroll
                    for (int e = 0; e < 8; ++e) x[e] = vp[(size_t)(8 * t8 + e) * 2048];
                    v4u o4; o4.x = x[0] | (x[1] << 16); o4.y = x[2] | (x[3] << 16); o4.z = x[4] | (x[5] << 16); o4.w = x[6] | (x[7] << 16); dst[t8] = o4; } }
        }
        __syncthreads();
        { const int t = tid >> 3, cb = tid & 7, c0 = 32 * cb;
          const v4u* qg = (const v4u*)(GQ + (size_t)(t0 + t) * 1024 + h * 256 + c0); const v4u* kg = (const v4u*)(GK + (size_t)(t0 + t) * 1024 + h * 256 + c0);
          float qv[32], kv[32];
#pragma unroll
          for (int e = 0; e < 4; ++e) { const v4u a = qg[e], b = kg[e];
              qv[8 * e] = bflo(a.x); qv[8 * e + 1] = bfhi(a.x); qv[8 * e + 2] = bflo(a.y); qv[8 * e + 3] = bfhi(a.y); qv[8 * e + 4] = bflo(a.z); qv[8 * e + 5] = bfhi(a.z); qv[8 * e + 6] = bflo(a.w); qv[8 * e + 7] = bfhi(a.w);
              kv[8 * e] = bflo(b.x); kv[8 * e + 1] = bfhi(b.x); kv[8 * e + 2] = bflo(b.y); kv[8 * e + 3] = bfhi(b.y); kv[8 * e + 4] = bflo(b.z); kv[8 * e + 5] = bfhi(b.z); kv[8 * e + 6] = bflo(b.w); kv[8 * e + 7] = bfhi(b.w); }
#pragma unroll
          for (int e4 = 0; e4 < 8; ++e4) { const f32x4v b4 = *(const LAS f32x4v*)(BC + t * 256 + c0 + 4 * e4);
#pragma unroll
              for (int j = 0; j < 4; ++j) { const float eb = __expf(b4[j]), ib = __expf(-b4[j]); qv[4 * e4 + j] *= eb * 0.0625f; kv[4 * e4 + j] *= ib; } }
          LAS v4u* ql = (LAS v4u*)(lds + GLP_QPB + t * GLP_STR + 64 * cb); LAS v4u* kl = (LAS v4u*)(lds + GLP_KPB + t * GLP_STR + 64 * cb);
#pragma unroll
          for (int e = 0; e < 4; ++e) { v4u a, b; a.x = pk2(qv[8 * e], qv[8 * e + 1]); a.y = pk2(qv[8 * e + 2], qv[8 * e + 3]); a.z = pk2(qv[8 * e + 4], qv[8 * e + 5]); a.w = pk2(qv[8 * e + 6], qv[8 * e + 7]);
              b.x = pk2(kv[8 * e], kv[8 * e + 1]); b.y = pk2(kv[8 * e + 2], kv[8 * e + 3]); b.z = pk2(kv[8 * e + 4], kv[8 * e + 5]); b.w = pk2(kv[8 * e + 6], kv[8 * e + 7]); ql[e] = a; kl[e] = b; }
          v4u* qd = (v4u*)(ops + GL_QP + t * 512 + 64 * cb);
#pragma unroll
          for (int g = 0; g < 4; ++g) { v4u o4; o4.x = pk2(qv[4 * g], qv[4 * g + 1]); o4.y = pk2(qv[4 * g + 2], qv[4 * g + 3]); o4.z = pk2(qv[16 + 4 * g], qv[16 + 4 * g + 1]); o4.w = pk2(qv[16 + 4 * g + 2], qv[16 + 4 * g + 3]); qd[g] = o4; } }
        __syncthreads();
#pragma unroll 1
        for (int tt = 0; tt < 2; ++tt) { const int task = 2 * w + tt, mi = task >> 2, nj = task & 3; const int j = 16 * nj + fr;
            if (mi >= nj) { f32x4v acc = {0.f, 0.f, 0.f, 0.f};
                const LAS unsigned char* ab = lds + GLP_QPB + (16 * mi + fr) * GLP_STR + 16 * fg; const LAS unsigned char* bb = lds + GLP_KPB + (16 * nj + fr) * GLP_STR + 16 * fg;
#pragma unroll
                for (int s = 0; s < 8; ++s) acc = __builtin_amdgcn_mfma_f32_16x16x32_bf16(*(const LAS bf16x8*)(ab + 64 * s), *(const LAS bf16x8*)(bb + 64 * s), acc, 0, 0, 0);
#pragma unroll
                for (int e = 0; e < 4; ++e) { const int i = 16 * mi + 4 * fg + e; *(bf16*)(ops + GL_AI + (i * 64 + j) * 2) = (bf16)f2bf(i >= j ? acc[e] : 0.f); }
            } else {
#pragma unroll
                for (int e = 0; e < 4; ++e) { const int i = 16 * mi + 4 * fg + e; *(bf16*)(ops + GL_AI + (i * 64 + j) * 2) = (bf16)0; } } }
        { const int c = tid >> 1, tb = tid & 1; const float el = __expf(BC[63 * 256 + c]); float v[32];
#pragma unroll
          for (int e = 0; e < 32; ++e) v[e] = bf2f(*(const LAS bf16*)(lds + GLP_KPB + (32 * tb + e) * GLP_STR + 2 * c)) * el;
          v4u* dst = (v4u*)(ops + GL_KDT + c * 128 + 64 * tb);
#pragma unroll
          for (int e = 0; e < 4; ++e) { v4u o4; o4.x = pk2(v[8 * e], v[8 * e + 1]); o4.y = pk2(v[8 * e + 2], v[8 * e + 3]); o4.z = pk2(v[8 * e + 4], v[8 * e + 5]); o4.w = pk2(v[8 * e + 6], v[8 * e + 7]); dst[e] = o4; }
          if (tid < 256) ((float*)(ops + GL_DL))[tid] = __expf(BC[63 * 256 + tid]); }
        __syncthreads();
    }
}

constexpr int GS2_QP = 0, GS2_AI = 33792, GS2_KDT = 43008, GS2_DL = 79872;
template <int PASS> __device__ __forceinline__ void gla_scan_phase(Frame& F, const unsigned char* OPS, float* E, float* DGP, float* OG) {
    if (blockIdx.x >= 256) return;
    const int tid = opaque_tid(), lane = tid & 63, w = F.wave, fr = lane & 15, fg = lane >> 4;
    const int idx = blockIdx.x, g = idx & 15, cb = (idx >> 4) & 3, h = idx >> 6;
    LAS unsigned char* lds = F.lds;
    const int colh = 128 * cb + 16 * w + fr;
    f32x4v Sf[16];
#pragma unroll
    for (int t = 0; t < 16; ++t) Sf[t] = (f32x4v){0.f, 0.f, 0.f, 0.f};
    if (PASS == 2) {
        for (int gp = 0; gp < g; ++gp) { const float* ep = E + ((size_t)(h * NGRP + gp) * 256) * 512 + colh; const float* dp = DGP + (size_t)(h * NGRP + gp) * 256;
#pragma unroll
            for (int t = 0; t < 16; ++t) { const f32x4v d4 = *(const f32x4v*)(dp + 16 * t + 4 * fg);
#pragma unroll
                for (int e = 0; e < 4; ++e) Sf[t][e] = Sf[t][e] * d4[e] + ep[(size_t)(16 * t + 4 * fg + e) * 512]; } }
    }
    const unsigned gof = (unsigned)tid * 16u;
    const unsigned lQ = (unsigned)((tid >> 5) * 528 + (tid & 31) * 16), lB = (unsigned)((tid >> 3) * 144 + (tid & 7) * 16);
    v4u pq[4], pa, pk[4], pd; v4u pv[2];
#define GL_LOAD(n) do { const unsigned char* o_ = OPS + (size_t)(h * 128 + (n)) * GL_UNIT; \
        if (PASS == 2) { _Pragma("unroll") for (int e_ = 0; e_ < 4; ++e_) pq[e_] = *(const v4u*)(o_ + GL_QP + gof + 8192 * e_); pa = *(const v4u*)(o_ + GL_AI + gof); } \
        _Pragma("unroll") for (int e_ = 0; e_ < 4; ++e_) pk[e_] = *(const v4u*)(o_ + GL_KDT + gof + 8192 * e_); \
        if (tid < 64) pd = *(const v4u*)(o_ + GL_DL + gof); \
        _Pragma("unroll") for (int s_ = 0; s_ < 2; ++s_) pv[s_] = *(const v4u*)(o_ + GL_VT + (size_t)colh * 128 + 64 * s_ + 16 * fg); } while (0)
#define GL_STORE() do { \
        if (PASS == 2) { _Pragma("unroll") for (int e_ = 0; e_ < 4; ++e_) *(LAS v4u*)(lds + GS2_QP + lQ + 16 * 528 * e_) = pq[e_]; *(LAS v4u*)(lds + GS2_AI + lB) = pa; } \
        _Pragma("unroll") for (int e_ = 0; e_ < 4; ++e_) *(LAS v4u*)(lds + GS2_KDT + lB + 64 * 144 * e_) = pk[e_]; \
        if (tid < 64) *(LAS v4u*)(lds + GS2_DL + gof) = pd; } while (0)
    const unsigned aQ = (unsigned)(fr * 528 + fg * 16), aB = (unsigned)(fr * 144 + fg * 16);
    float dprod = 1.0f;
    GL_LOAD(GCH * g);
    for (int nn = 0; nn < GCH; ++nn) {
        const int n = GCH * g + nn;
        __syncthreads();
        GL_STORE();
        bf16x8 Vb[2]; Vb[0] = __builtin_bit_cast(bf16x8, pv[0]); Vb[1] = __builtin_bit_cast(bf16x8, pv[1]);
        __syncthreads();
        if (nn + 1 < GCH) GL_LOAD(n + 1);
        if (PASS == 1 && cb == 0 && tid < 256) dprod *= *(const LAS float*)(lds + GS2_DL + 4 * tid);
        if (PASS == 2) {
            bf16x8 Sb[8];
#pragma unroll
            for (int s = 0; s < 8; ++s) { v4u t; t.x = cvtpk(Sf[2 * s][0], Sf[2 * s][1]); t.y = cvtpk(Sf[2 * s][2], Sf[2 * s][3]); t.z = cvtpk(Sf[2 * s + 1][0], Sf[2 * s + 1][1]); t.w = cvtpk(Sf[2 * s + 1][2], Sf[2 * s + 1][3]); Sb[s] = __builtin_bit_cast(bf16x8, t); }
#pragma unroll
            for (int m = 0; m < 4; ++m) { f32x4v a = {0.f, 0.f, 0.f, 0.f};
#pragma unroll
                for (int s = 0; s < 8; ++s) a = __builtin_amdgcn_mfma_f32_16x16x32_bf16(*(const LAS bf16x8*)(lds + GS2_QP + aQ + m * 16 * 528 + s * 64), Sb[s], a, 0, 0, 0);
#pragma unroll
                for (int s = 0; s < 2; ++s) a = __builtin_amdgcn_mfma_f32_16x16x32_bf16(*(const LAS bf16x8*)(lds + GS2_AI + aB + m * 16 * 144 + s * 64), Vb[s], a, 0, 0, 0);
                float* op = OG + (size_t)(64 * n + 16 * m + 4 * fg) * 2048 + h * 512 + colh;
#pragma unroll
                for (int e = 0; e < 4; ++e) op[(size_t)e * 2048] = a[e]; }
        }
#pragma unroll
        for (int t = 0; t < 16; ++t) { const f32x4v d4 = *(const LAS f32x4v*)(lds + GS2_DL + (16 * t + 4 * fg) * 4); f32x4v a = Sf[t] * d4;
#pragma unroll
            for (int s = 0; s < 2; ++s) a = __builtin_amdgcn_mfma_f32_16x16x32_bf16(*(const LAS bf16x8*)(lds + GS2_KDT + aB + t * 16 * 144 + s * 64), Vb[s], a, 0, 0, 0);
            Sf[t] = a; }
    }
#undef GL_LOAD
#undef GL_STORE
    if (PASS == 1) {
        float* ep = E + ((size_t)(h * NGRP + g) * 256) * 512 + colh;
#pragma unroll
        for (int t = 0; t < 16; ++t)
#pragma unroll
            for (int e = 0; e < 4; ++e) ep[(size_t)(16 * t + 4 * fg + e) * 512] = Sf[t][e];
        if (cb == 0 && tid < 256) DGP[(size_t)(h * NGRP + g) * 256 + tid] = dprod;
    }
    __syncthreads();
}
constexpr int ATT_B0 = 8;
constexpr int PPL = 10, NPH = 2 + PPL * NLAYER;
__global__ void __launch_bounds__(NWAVES * 64, 2) fwd(Args a) {
    extern __shared__ __attribute__((aligned(16))) unsigned char lds[];
    Frame F;
    F.lds = (LAS unsigned char*)lds; F.ldsg = lds; F.MISC = (volatile LAS unsigned*)(F.lds + MISC_OFF);
    F.wave = __builtin_amdgcn_readfirstlane((int)threadIdx.x >> 6);
    F.G = gridDim.x; F.gw = blockIdx.x * NWAVES + F.wave; F.NGW = F.G * NWAVES;
    F.ws = a.ws; F.ctl = (gu32*)(a.ws + WS_CTL);
    for (int u = threadIdx.x; u < (LDS_BYTES - LDSCTL_OFF) / 4; u += NWAVES * 64) ((LAS unsigned*)(F.lds + LDSCTL_OFF))[u] = 0u;
    __syncthreads();
    const int lo = a.ph_lo, hi = a.ph_hi;
    XcdBarrier bar; bar.bar = (unsigned*)(F.ctl + CW_BAR); bar.x = 0; bar.st = nullptr;
    if (hi - lo > 1) bar = xcd_barrier_post((unsigned*)(F.ctl + CW_BAR), F.MISC + 8);
#define IN(k) (lo <= (k) && (k) < hi)
#define SEAM(k) do { if (IN(k) && IN((k) + 1)) xcd_barrier(bar); } while (0)
    unsigned char* ws = a.ws;
    bf16* H = (bf16*)(ws + WS_H); bf16* MIX = (bf16*)(ws + WS_MIX); bf16* HID = (bf16*)(ws + WS_HID);
    float* SSQ = (float*)(ws + WS_SSQ); float* BA = (float*)(ws + WS_BA); const float* cosT = (const float*)(ws + WS_COS); const float* sinT = (const float*)(ws + WS_SIN);
    float* OG = (float*)(ws + WS_OG); const float* MODS = (const float*)(ws + WS_MODS);
    float* X = a.out;
    const int vcu = (F.G % 8 == 0) ? ((int)blockIdx.x % 8) * (F.G / 8) + (int)blockIdx.x / 8 : (int)blockIdx.x;

    if (IN(0)) { p0_prologue(F, a); } SEAM(0);

    for (int L = 0; L < NLAYER; ++L) {
        const int base = 1 + PPL * L, i = L >> 1; const bool odd = (L & 1) != 0;
        const float* xin0 = (L == 0) ? (const float*)a.in[0] : (const float*)X;
        bf16* CQ = (bf16*)(ws + WS_PROJ); bf16* CKV = CQ + (size_t)TOK * 512; bf16* QKV = CKV + (size_t)TOK * 512; bf16* Z = QKV + (size_t)TOK * 3072;
        bf16* GQ = (bf16*)(ws + WS_PROJ); bf16* GK = GQ + (size_t)TOK * 1024; bf16* GV = GK + (size_t)TOK * 1024; bf16* GR = GV + (size_t)TOK * 2048;
        bf16* QH = (bf16*)(ws + WS_QH); bf16* KH = (bf16*)(ws + WS_KH); bf16* VT = (bf16*)(ws + WS_VT);
        unsigned char* GDOPS = ws + WS_SCR + 100 * MiB; unsigned char* GLOPS = ws + WS_SCR; float* GLE = (float*)(ws + WS_SCR + 72 * MiB); float* GLD = (float*)(ws + WS_SCR + 104 * MiB);

        if (IN(base + 0)) norm_phase<0>(F, a, xin0, (const float*)a.in[3] + (size_t)(2 * L) * DM, 2 * L, H, nullptr);
        SEAM(base + 0);
        if (IN(base + 1)) {
            if (!odd) { pg8::Gemm g{H, (const bf16*)(ws + WS_WEIN) + (size_t)i * EIN_NP * DM, TOK, EIN_NP, DM}; pg8::StaticOrder S; S.init(TOK, EIN_NP, F.G, (int)blockIdx.x);
                pg8::EpiEvenIn E{CQ, CKV, QKV, Z, KH, SSQ, BA, cosT, sinT};
                pg8::gemm_phase<pg8::EpiEvenIn, pg8::StaticOrder, true, true>(F.lds, g, S, E);
            } else { pg8::Gemm g{H, (const bf16*)(ws + WS_WOIN) + (size_t)i * OIN_NP * DM, TOK, OIN_NP, DM}; pg8::StaticOrder S; S.init(TOK, OIN_NP, F.G, (int)blockIdx.x);
                pg8::EpiOddIn E{GQ, GK, GV, GR};
                pg8::gemm_phase<pg8::EpiOddIn, pg8::StaticOrder, true, true>(F.lds, g, S, E); }
        }
        SEAM(base + 1);
        if (IN(base + 2)) {
            if (!odd) {
                { pg8::Gemm g{CQ, (const bf16*)(ws + WS_WUQ) + (size_t)i * 1536 * 512, TOK, 1536, 512}; pg8::StaticOrder S; S.init(TOK, 1536, F.G, (int)blockIdx.x);
                  pg8::EpiUq E{QH, SSQ, cosT, sinT, 0.10411754112770776f};
                  pg8::gemm_phase<pg8::EpiUq, pg8::StaticOrder, true, true>(F.lds, g, S, E); }
                { pg8::Gemm g{CKV, (const bf16*)(ws + WS_WUKV) + (size_t)i * 2048 * 512, TOK, 2048, 512}; pg8::StaticOrder S; S.init(TOK, 2048, F.G, (int)blockIdx.x);
                  pg8::EpiUkv E{KH, VT, SSQ};
                  pg8::gemm_phase<pg8::EpiUkv, pg8::StaticOrder, true, true>(F.lds, g, S, E); }
                gdn_prep_phase(F, QKV, BA, (const float*)a.in[11] + (size_t)i * 4 * 3072, (const float*)a.in[12] + i * 8, (const float*)a.in[13] + i * 8, GDOPS);
            } else gla_prep_phase(F, H, (const bf16*)(ws + WS_WGL) + (size_t)i * 16 * DM, (const float*)a.in[17] + (size_t)i * 16 * 1024, (const float*)a.in[18] + i * 1024, GQ, GK, GV, GLOPS);
        }
        SEAM(base + 2);
        if (IN(base + 3)) {
            if (!odd) {
                if (vcu < ATT_B0) gdn_scan_phase(F, GDOPS, Z, (const float*)a.in[14] + i * 128, MIX, vcu);
                else attn_phase(F, QH, KH, VT, MIX, (float*)(ws + WS_SCR), (float*)(ws + WS_SCR + AT_OPART_BYTES), vcu, ATT_B0);
            } else gla_scan_phase<1>(F, GLOPS, GLE, GLD, OG);
        }
        SEAM(base + 3);
        if (IN(base + 4)) {
            if (!odd) attn_merge_phase(F, (const float*)(ws + WS_SCR), (const float*)(ws + WS_SCR + AT_OPART_BYTES), MIX, ATT_B0);
            else gla_scan_phase<2>(F, GLOPS, GLE, GLD, OG);
        }
        SEAM(base + 4);
        if (IN(base + 5)) { if (odd) gatenorm_phase<512>(F, OG, 2048, (const float*)a.in[19] + i * 512, GR, 2048, MIX, 0); }
        if (odd) SEAM(base + 5);
        if (IN(base + 6)) {
            const bf16* Wt = odd ? (const bf16*)(ws + WS_WOOUT) + (size_t)i * DM * DM : (const bf16*)(ws + WS_WEOUT) + (size_t)i * DM * DM;
            pg8::Gemm g{MIX, Wt, TOK, DM, DM}; pg8::StaticOrder S; S.init(TOK, DM, F.G, (int)blockIdx.x);
            pg8::EpiResid E{xin0, X, MODS + (size_t)(2 * L) * 2048};
            pg8::gemm_phase<pg8::EpiResid, pg8::StaticOrder, true, true>(F.lds, g, S, E);
        }
        SEAM(base + 6);
        if (IN(base + 7)) norm_phase<0>(F, a, X, (const float*)a.in[3] + (size_t)(2 * L + 1) * DM, 2 * L + 1, H, nullptr);
        SEAM(base + 7);
        if (IN(base + 8)) {
            pg8::Gemm g{H, (const bf16*)(ws + WS_W13) + (size_t)L * 2 * DFF * DM, TOK, 2 * DFF, DM}; pg8::StaticOrder S; S.init(TOK, 2 * DFF, F.G, (int)blockIdx.x);
            pg8::EpiFfnUp E{HID};
            pg8::gemm_phase<pg8::EpiFfnUp, pg8::StaticOrder, true, true>(F.lds, g, S, E);
        }
        SEAM(base + 8);
        if (IN(base + 9)) {
            pg8::Gemm g{HID, (const bf16*)(ws + WS_W2) + (size_t)L * DM * DFF, TOK, DM, DFF}; pg8::StaticOrder S; S.init(TOK, DM, F.G, (int)blockIdx.x);
            pg8::EpiResid E{X, X, MODS + (size_t)(2 * L + 1) * 2048};
            pg8::gemm_phase<pg8::EpiResid, pg8::StaticOrder, true, true>(F.lds, g, S, E);
        }
        SEAM(base + 9);
    }
    if (IN(NPH - 1)) norm_phase<1>(F, a, X, (const float*)a.in[24], 0, nullptr, X);
#undef IN
#undef SEAM
}

extern "C" void kernel_launch(void* const* d_in, const int* in_sizes, int n_in, void* d_out, int out_size, void* d_ws, size_t ws_size, hipStream_t stream) {
    static int grid = 0;
    if (grid == 0) {
        if (n_in != 25 || out_size != TOK * DM || ws_size < WS_END) { fprintf(stderr, "kernel_launch: unexpected shapes (n_in %d, out %d, ws %zu < %zu)\n", n_in, out_size, ws_size, (size_t)WS_END); grid = -1; return; }
        int dev = 0, cus = 0;
        if (hipGetDevice(&dev) != hipSuccess || hipDeviceGetAttribute(&cus, hipDeviceAttributeMultiprocessorCount, dev) != hipSuccess) { grid = -1; return; }
        if (hipFuncSetAttribute((const void*)fwd, hipFuncAttributeMaxDynamicSharedMemorySize, LDS_BYTES) != hipSuccess) { fprintf(stderr, "kernel_launch: hipFuncSetAttribute failed\n"); grid = -1; return; }
        int per_cu = 0; (void)hipOccupancyMaxActiveBlocksPerMultiprocessor(&per_cu, (const void*)fwd, NWAVES * 64, LDS_BYTES); (void)hipGetLastError();
        if (per_cu < 1) fprintf(stderr, "kernel_launch: occupancy query reports %d blocks per CU\n", per_cu);
        grid = cus;
    }
    if (grid < 0) return;
    (void)hipMemsetAsync((char*)d_ws + WS_CTL, 0, CTL_ZERO_BYTES, stream);
    Args a{};
    for (int i = 0; i < 25; ++i) a.in[i] = d_in[i];
    a.out = (float*)d_out; a.ws = (unsigned char*)d_ws;
    auto run = [&](int lo, int hi) { a.ph_lo = lo; a.ph_hi = hi; hipLaunchKernelGGL(fwd, dim3(grid), dim3(NWAVES * 64), LDS_BYTES, stream, a); };
#if defined(MK_PER_PHASE)
    for (int p = 0; p < NPH; ++p) run(p, p + 1);
#else
    run(0, NPH);
#endif
}
```

```cpp
#include <hip/hip_runtime.h>
#include <cstdio>
#include <cstdint>

namespace pg8 {
#define PG8_LAS __attribute__((address_space(3)))
typedef unsigned short bf16_t;
typedef short bf16x8 __attribute__((ext_vector_type(8)));
typedef float f32x4 __attribute__((ext_vector_type(4)));
typedef unsigned u32x4 __attribute__((ext_vector_type(4)));
constexpr int BM = 256, BK = 64, HALF = 128, HTB = HALF * BK * 2  , STAGE_BYTES = 8 * HTB, NXCD = 8, WGM = 8;

__host__ __device__ __forceinline__ int lds_byte(int r, int c) { const int st = (r >> 4) * 2 + (c >> 5), rr = r & 15, cc = c & 31, ob = rr * 64 + cc * 2; return st * 1024 + (ob ^ (((ob >> 9) & 1) << 5)); }
__host__ __device__ __forceinline__ void stage_rc(int b, int& R, int& C) { const int st = b / 1024, sb = b % 1024, swz = sb ^ (((sb >> 9) & 1) << 5); R = (st >> 1) * 16 + swz / 64; C = (st & 1) * 32 + (swz % 64) / 2; }
__host__ __device__ __forceinline__ int perm32(int rho) { const int n = rho >> 4, i = rho & 15; return 8 * (i >> 2) + 4 * n + (i & 3); }

struct Unit { int pm, pn; };
struct Gemm { const bf16_t* A; const bf16_t* Bt; int M, N, K; };

struct StaticOrder {
    int nM, nN, nwg, G, c;
    __host__ __device__ void init(int M, int N, int G_, int c_) { nM = M / BM; nN = N / BM; nwg = nM * nN; G = G_; c = c_; }
    __host__ __device__ bool next(int i, Unit& u) const {
        const long L = (long)i * G + c; if (L >= nwg) return false;
        int wgid = (int)L; { const int q = nwg / NXCD, r = nwg % NXCD, xcd = wgid % NXCD, off = wgid / NXCD; wgid = (xcd < r ? xcd * (q + 1) : r * (q + 1) + (xcd - r) * q) + off; }
        const int nig = WGM * nN, gid = wgid / nig, fm = gid * WGM, gsz = (nM - fm) < WGM ? (nM - fm) : WGM;
        u.pm = fm + ((wgid % nig) % gsz); u.pn = (wgid % nig) / gsz; return true;
    }
    __device__ __forceinline__ void a_ready(const Unit&) const {}
    __device__ __forceinline__ void done(const Unit&) const {}
};

__device__ __forceinline__ unsigned cvt_pk_bf16(float lo, float hi) { unsigned r; asm volatile("v_cvt_pk_bf16_f32 %0, %1, %2" : "=v"(r) : "v"(lo), "v"(hi)); return r; }
typedef float f32x2 __attribute__((ext_vector_type(2)));
__device__ __forceinline__ u32x4 pack8(const f32x4& a, const f32x4& b) { u32x4 w; w.x = cvt_pk_bf16(a[0], a[1]); w.y = cvt_pk_bf16(a[2], a[3]); w.z = cvt_pk_bf16(b[0], b[1]); w.w = cvt_pk_bf16(b[2], b[3]); return w; }
__device__ __forceinline__ float sumsq4(const f32x4& a) { return (a[0] * a[0] + a[1] * a[1]) + (a[2] * a[2] + a[3] * a[3]); }
__device__ __forceinline__ void rope8(f32x4& v0, f32x4& v1, const f32x4& c4, const f32x4& s4) {
    const f32x4 a = v0, b = v1;
    v0[0] = a[0] * c4[0] - a[1] * s4[0]; v0[1] = a[1] * c4[0] + a[0] * s4[0];
    v0[2] = a[2] * c4[1] - a[3] * s4[1]; v0[3] = a[3] * c4[1] + a[2] * s4[1];
    v1[0] = b[0] * c4[2] - b[1] * s4[2]; v1[1] = b[1] * c4[2] + b[0] * s4[2];
    v1[2] = b[2] * c4[3] - b[3] * s4[3]; v1[3] = b[3] * c4[3] + b[2] * s4[3];
}
constexpr int TOK = 8192;
struct EpiEvenIn {
    static constexpr bool PERM = true, AFTER_DRAIN = false;
    bf16_t *CQ, *CKV, *QKV, *Z, *KH; float *SSQ, *BA; const float *cosT, *sinT;
    __device__ __forceinline__ void operator()(const f32x4 (&acc)[2][2][4][2], const Unit& u, int wr, int wc, int fr_in, int fq_in) const {
        int fr = fr_in, fq = fq_in; asm volatile("" : "+v"(fr), "+v"(fq));
        const int row0 = u.pm * BM + wr * 64 + fr;
        if (u.pn < 20) {
            bf16_t* base; int ldc, colt;
            if (u.pn < 2) { base = CQ; ldc = 512; colt = u.pn * 256; } else if (u.pn < 4) { base = CKV; ldc = 512; colt = (u.pn - 2) * 256; }
            else if (u.pn < 16) { base = QKV; ldc = 3072; colt = (u.pn - 4) * 256; } else { base = Z; ldc = 1024; colt = (u.pn - 16) * 256; }
            const int col0 = colt + wc * 32 + 8 * fq;
#pragma unroll
            for (int ai = 0; ai < 2; ++ai)
#pragma unroll
                for (int m = 0; m < 4; ++m) { const int row = row0 + ai * HALF + m * 16; bf16_t* rowp = base + (size_t)row * ldc + col0; float ss = 0.f;
#pragma unroll
                    for (int bj = 0; bj < 2; ++bj) { const f32x4 v0 = acc[ai][bj][m][0], v1 = acc[ai][bj][m][1]; ss += sumsq4(v0) + sumsq4(v1); *(u32x4*)(rowp + bj * HALF) = pack8(v0, v1); }
                    if (u.pn < 4) { const int ln = fq * 16 + fr; ss += __builtin_bit_cast(float, __builtin_amdgcn_ds_bpermute((ln ^ 16) << 2, __builtin_bit_cast(int, ss))); ss += __builtin_bit_cast(float, __builtin_amdgcn_ds_bpermute((ln ^ 32) << 2, __builtin_bit_cast(int, ss))); if (fq == 0) SSQ[(size_t)row * 16 + u.pn * 4 + wc] = ss; } }
        } else {
            if (wc < 2) {
#pragma unroll
                for (int ai = 0; ai < 2; ++ai)
#pragma unroll
                    for (int m = 0; m < 4; ++m) { const int row = row0 + ai * HALF + m * 16; f32x4 v0 = acc[ai][0][m][0], v1 = acc[ai][0][m][1];
                        const int i0 = 16 * wc + 4 * fq; const f32x4 c4 = *(const f32x4*)(cosT + (size_t)row * 32 + i0), s4 = *(const f32x4*)(sinT + (size_t)row * 32 + i0);
                        rope8(v0, v1, c4, s4); const u32x4 w = pack8(v0, v1);
#pragma unroll
                        for (int h = 0; h < 8; ++h) *(u32x4*)(KH + ((size_t)h * TOK + row) * 192 + 128 + 32 * wc + 8 * fq) = w; }
            } else if (wc == 2) {
                if (fq < 2) {
#pragma unroll
                    for (int ai = 0; ai < 2; ++ai)
#pragma unroll
                        for (int m = 0; m < 4; ++m) { const int row = row0 + ai * HALF + m * 16; float* p = BA + (size_t)row * 16 + 8 * fq; *(f32x4*)p = acc[ai][0][m][0]; *(f32x4*)(p + 4) = acc[ai][0][m][1]; }
                }
            }
        }
    }
};
struct EpiUq {
    static constexpr bool PERM = true, AFTER_DRAIN = false;
    bf16_t* QH; const float* SSQ; const float *cosT, *sinT; float qscale;
    __device__ __forceinline__ void operator()(const f32x4 (&acc)[2][2][4][2], const Unit& u, int wr, int wc, int fr_in, int fq_in) const {
        int fr = fr_in, fq = fq_in; asm volatile("" : "+v"(fr), "+v"(fq));
        const int row0 = u.pm * BM + wr * 64 + fr;
#pragma unroll
        for (int ai = 0; ai < 2; ++ai)
#pragma unroll
            for (int m = 0; m < 4; ++m) { const int row = row0 + ai * HALF + m * 16;
                const f32x4 p0 = *(const f32x4*)(SSQ + (size_t)row * 16), p1 = *(const f32x4*)(SSQ + (size_t)row * 16 + 4);
                const float ssum = ((p0[0] + p0[1]) + (p0[2] + p0[3])) + ((p1[0] + p1[1]) + (p1[2] + p1[3]));
                const float rq = rsqrtf(ssum * (1.0f / 512.0f) + 1e-6f) * qscale;
#pragma unroll
                for (int bj = 0; bj < 2; ++bj) { const int c8 = u.pn * BM + bj * HALF + wc * 32 + 8 * fq; const int head = c8 / 192, d = c8 - head * 192;
                    f32x4 v0 = acc[ai][bj][m][0] * rq, v1 = acc[ai][bj][m][1] * rq;
                    if (d >= 128) { const int i0 = (d - 128) >> 1; const f32x4 c4 = *(const f32x4*)(cosT + (size_t)row * 32 + i0), s4 = *(const f32x4*)(sinT + (size_t)row * 32 + i0); rope8(v0, v1, c4, s4); }
                    *(u32x4*)(QH + ((size_t)head * TOK + row) * 192 + d) = pack8(v0, v1); } }
    }
};
struct EpiUkv {
    static constexpr bool PERM = true, AFTER_DRAIN = false;
    bf16_t *KH, *VT; const float* SSQ;
    __device__ __forceinline__ void operator()(const f32x4 (&acc)[2][2][4][2], const Unit& u, int wr, int wc, int fr_in, int fq_in) const {
        int fr = fr_in, fq = fq_in; asm volatile("" : "+v"(fr), "+v"(fq));
        const int row0 = u.pm * BM + wr * 64 + fr, head = u.pn;
#pragma unroll
        for (int ai = 0; ai < 2; ++ai)
#pragma unroll
            for (int m = 0; m < 4; ++m) { const int row = row0 + ai * HALF + m * 16;
                const f32x4 p0 = *(const f32x4*)(SSQ + (size_t)row * 16 + 8), p1 = *(const f32x4*)(SSQ + (size_t)row * 16 + 12);
                const float ssum = ((p0[0] + p0[1]) + (p0[2] + p0[3])) + ((p1[0] + p1[1]) + (p1[2] + p1[3]));
                const float rk = rsqrtf(ssum * (1.0f / 512.0f) + 1e-6f);
                { const f32x4 v0 = acc[ai][0][m][0] * rk, v1 = acc[ai][0][m][1] * rk; *(u32x4*)(KH + ((size_t)head * TOK + row) * 192 + wc * 32 + 8 * fq) = pack8(v0, v1); }
                { const f32x4 v0 = acc[ai][1][m][0] * rk, v1 = acc[ai][1][m][1] * rk; const u32x4 w = pack8(v0, v1); bf16_t* vp = VT + ((size_t)head * 128 + wc * 32 + 8 * fq) * TOK + row;
                  vp[0 * TOK] = (bf16_t)(w.x & 0xffffu); vp[1 * TOK] = (bf16_t)(w.x >> 16); vp[2 * TOK] = (bf16_t)(w.y & 0xffffu); vp[3 * TOK] = (bf16_t)(w.y >> 16);
                  vp[4 * TOK] = (bf16_t)(w.z & 0xffffu); vp[5 * TOK] = (bf16_t)(w.z >> 16); vp[6 * TOK] = (bf16_t)(w.w & 0xffffu); vp[7 * TOK] = (bf16_t)(w.w >> 16); } }
    }
};
struct EpiOddIn {
    static constexpr bool PERM = true, AFTER_DRAIN = false;
    bf16_t *Q, *K, *V, *R;
    __device__ __forceinline__ void operator()(const f32x4 (&acc)[2][2][4][2], const Unit& u, int wr, int wc, int fr_in, int fq_in) const {
        int fr = fr_in, fq = fq_in; asm volatile("" : "+v"(fr), "+v"(fq));
        const int row0 = u.pm * BM + wr * 64 + fr;
        bf16_t* base; int ldc, colt;
        if (u.pn < 4) { base = Q; ldc = 1024; colt = u.pn * 256; } else if (u.pn < 8) { base = K; ldc = 1024; colt = (u.pn - 4) * 256; }
        else if (u.pn < 16) { base = V; ldc = 2048; colt = (u.pn - 8) * 256; } else { base = R; ldc = 2048; colt = (u.pn - 16) * 256; }
        const int col0 = colt + wc * 32 + 8 * fq;
#pragma unroll
        for (int ai = 0; ai < 2; ++ai)
#pragma unroll
            for (int m = 0; m < 4; ++m) { bf16_t* rowp = base + (size_t)(row0 + ai * HALF + m * 16) * ldc + col0;
#pragma unroll
                for (int bj = 0; bj < 2; ++bj) *(u32x4*)(rowp + bj * HALF) = pack8(acc[ai][bj][m][0], acc[ai][bj][m][1]); }
    }
};
struct EpiResid {
    static constexpr bool PERM = false, AFTER_DRAIN = false;
    const float* xin; float* xout; const float* gate;
    __device__ __forceinline__ void operator()(const f32x4 (&acc)[2][2][4][2], const Unit& u, int wr, int wc, int fr_in, int fq_in) const {
        int fr = fr_in, fq = fq_in; asm volatile("" : "+v"(fr), "+v"(fq));
        const int row0 = u.pm * BM + wr * 64 + fr, col0 = u.pn * BM + wc * 32 + 4 * fq;
        f32x4 gv[2][2];
#pragma unroll
        for (int bj = 0; bj < 2; ++bj)
#pragma unroll
            for (int n = 0; n < 2; ++n) gv[bj][n] = *(const f32x4*)(gate + col0 + bj * HALF + n * 16);
#pragma unroll
        for (int ai = 0; ai < 2; ++ai)
#pragma unroll
            for (int m = 0; m < 4; ++m) { const size_t off = (size_t)(row0 + ai * HALF + m * 16) * 2048 + col0;
#pragma unroll
                for (int bj = 0; bj < 2; ++bj)
#pragma unroll
                    for (int n = 0; n < 2; ++n) { const f32x4 x = *(const f32x4*)(xin + off + bj * HALF + n * 16); *(f32x4*)(xout + off + bj * HALF + n * 16) = x + gv[bj][n] * acc[ai][bj][m][n]; } }
    }
};
struct EpiFfnUp {
    static constexpr bool PERM = true, AFTER_DRAIN = false;
    bf16_t* HID;
    __device__ __forceinline__ void operator()(const f32x4 (&acc)[2][2][4][2], const Unit& u, int wr, int wc, int fr_in, int fq_in) const {
        int fr = fr_in, fq = fq_in; asm volatile("" : "+v"(fr), "+v"(fq));
        const int row0 = u.pm * BM + wr * 64 + fr, colh = u.pn * 128 + wc * 32 + 8 * fq;
#pragma unroll
        for (int ai = 0; ai < 2; ++ai)
#pragma unroll
            for (int m = 0; m < 4; ++m) { f32x4 h4[2];
#pragma unroll
                for (int bj = 0; bj < 2; ++bj) { const f32x4 a = acc[ai][bj][m][0], b = acc[ai][bj][m][1];
#pragma unroll
                    for (int j = 0; j < 4; ++j) h4[bj][j] = a[j] * __builtin_amdgcn_rcpf(1.0f + __builtin_amdgcn_exp2f(-1.4426950408889634f * a[j])) * b[j]; }
                *(u32x4*)(HID + (size_t)(row0 + ai * HALF + m * 16) * 5632 + colh) = pack8(h4[0], h4[1]); }
    }
};
template <class Epi, class Sched, bool ALIGN_EPI = false, bool SP2 = false>
__device__ __forceinline__ void gemm_phase(PG8_LAS unsigned char* lds, const Gemm g, const Sched& S, const Epi& E) {
    int tid_l = threadIdx.x; asm volatile("" : "+v"(tid_l));
    const int tid = tid_l, wid = __builtin_amdgcn_readfirstlane(tid >> 6), lane = tid & 63, wr = wid >> 2, wc = wid & 3, fr = lane & 15, fq = lane >> 4;
    const int K = g.K, nt = K / BK;
    unsigned voffA[2], voffB[2];
#pragma unroll
    for (int i = 0; i < 2; ++i) { int R, C; stage_rc(tid * 16 + i * 8192, R, C); const int Rb = Epi::PERM ? ((R & ~31) + perm32(R & 31)) : R;
        voffA[i] = (unsigned)(R * K + C) * 2u; voffB[i] = (unsigned)(Rb * K + C) * 2u; }
    const size_t kstep = (size_t)(BK * 2);
    const size_t hstep = (size_t)HALF * K * 2;
    const size_t tstep = 2 * hstep;
    const unsigned ldsw = (unsigned)wid * 1024u;
    const int aoff = lds_byte(wr * 64 + fr, fq * 8), boff = lds_byte(wc * 32 + fr, fq * 8);
#define PG8_SA(b, h) (((b) * 2 + (h)) * HTB)
#define PG8_SB(b, h) ((4 + (b) * 2 + (h)) * HTB)
#define PG8_STAGE(bufoff, gbase, voff) do { _Pragma("unroll") for (int _i = 0; _i < 2; ++_i) \
        __builtin_amdgcn_global_load_lds((const unsigned*)((const char*)(gbase) + (voff)[_i]), (PG8_LAS unsigned*)(lds + (bufoff) + ldsw + _i * 8192), 16, 0, 0); } while (0)
#define PG8_LDA(dst, b, h) do { _Pragma("unroll") for (int m = 0; m < 4; ++m) _Pragma("unroll") for (int k = 0; k < 2; ++k) dst[m][k] = *(const PG8_LAS bf16x8*)(lds + PG8_SA(b, h) + aoff + m * 2048 + k * 1024); } while (0)
#define PG8_LDB(dst, b, h) do { _Pragma("unroll") for (int n = 0; n < 2; ++n) _Pragma("unroll") for (int k = 0; k < 2; ++k) dst[n][k] = *(const PG8_LAS bf16x8*)(lds + PG8_SB(b, h) + boff + n * 2048 + k * 1024); } while (0)
#define PG8_MMA(ai, bj, At, Bt) do { __builtin_amdgcn_s_setprio(1); _Pragma("unroll") for (int m = 0; m < 4; ++m) _Pragma("unroll") for (int n = 0; n < 2; ++n) _Pragma("unroll") for (int k = 0; k < 2; ++k) \
        acc[ai][bj][m][n] = __builtin_amdgcn_mfma_f32_16x16x32_bf16(Bt[n][k], At[m][k], acc[ai][bj][m][n], 0, 0, 0); __builtin_amdgcn_s_setprio(0); } while (0)
#define PG8_WAIT_V(n) asm volatile("s_waitcnt vmcnt(" #n ")" ::: "memory")
#define PG8_WAIT_L(n) asm volatile("s_waitcnt lgkmcnt(" #n ")" ::: "memory")
#define PG8_BAR __builtin_amdgcn_s_barrier()
#define PG8_SCHED __builtin_amdgcn_sched_barrier(0)
    Unit cur, nxt; int ui = 0;
    if (!S.next(0, cur)) return;
    f32x4 acc[2][2][4][2];
#pragma unroll
    for (int a = 0; a < 2; ++a)
#pragma unroll
        for (int b = 0; b < 2; ++b)
#pragma unroll
            for (int m = 0; m < 4; ++m)
#pragma unroll
                for (int n = 0; n < 2; ++n) acc[a][b][m][n] = (f32x4){0.f, 0.f, 0.f, 0.f};
    bf16x8 At[4][2], B0[2][2], B1[2][2];
    const char* cA = (const char*)g.A + (size_t)cur.pm * tstep; const char* cB = (const char*)g.Bt + (size_t)cur.pn * tstep;
    S.a_ready(cur);
    if constexpr (SP2) {
        PG8_STAGE(PG8_SB(0, 0), cB, voffB); PG8_STAGE(PG8_SB(0, 1), cB + hstep, voffB); PG8_STAGE(PG8_SA(0, 0), cA, voffA); PG8_STAGE(PG8_SA(0, 1), cA + hstep, voffA);
        if (wr == 1) PG8_BAR;
        PG8_WAIT_V(2); PG8_BAR;
        PG8_STAGE(PG8_SB(1, 0), cB + kstep, voffB); PG8_STAGE(PG8_SA(1, 0), cA + kstep, voffA); PG8_STAGE(PG8_SB(1, 1), cB + hstep + kstep, voffB);
        PG8_WAIT_V(6); PG8_BAR;
    } else {
        PG8_STAGE(PG8_SB(0, 0), cB, voffB); PG8_STAGE(PG8_SA(0, 0), cA, voffA); PG8_STAGE(PG8_SB(0, 1), cB + hstep, voffB); PG8_STAGE(PG8_SA(0, 1), cA + hstep, voffA);
        if (wr == 1) PG8_BAR;
        PG8_WAIT_V(4); PG8_BAR;
        PG8_STAGE(PG8_SB(1, 0), cB + kstep, voffB); PG8_STAGE(PG8_SA(1, 0), cA + kstep, voffA); PG8_STAGE(PG8_SB(1, 1), cB + hstep + kstep, voffB);
        PG8_WAIT_V(6); PG8_BAR;
    }
    for (;;) {
        const bool has_next = S.next(ui + 1, nxt);
        const char* nA = has_next ? (const char*)g.A + (size_t)nxt.pm * tstep : cA; const char* nB = has_next ? (const char*)g.Bt + (size_t)nxt.pn * tstep : cB;
        for (int t = 0; t < nt; t += 2) {
            const bool last = (t == nt - 2);
            const char* a1 = cA + (size_t)(t + 1) * kstep;
            const char* a2 = last ? nA : cA + (size_t)(t + 2) * kstep; const char* b2 = last ? nB : cB + (size_t)(t + 2) * kstep;
            const char* a3 = a2 + kstep; const char* b3 = b2 + kstep;
            if (last && has_next) S.a_ready(nxt);
            if constexpr (SP2) {
            PG8_LDB(B0, 0, 0); PG8_LDB(B1, 0, 1); PG8_SCHED; PG8_LDA(At, 0, 0); PG8_STAGE(PG8_SA(1, 1), a1 + hstep, voffA);
            PG8_WAIT_V(8); PG8_WAIT_L(0); PG8_BAR; PG8_MMA(0, 0, At, B0); PG8_MMA(0, 1, At, B1); PG8_BAR; PG8_SCHED;
            PG8_LDA(At, 0, 1); PG8_STAGE(PG8_SB(0, 0), b2, voffB); PG8_STAGE(PG8_SB(0, 1), b2 + hstep, voffB); PG8_STAGE(PG8_SA(0, 0), a2, voffA);
            PG8_WAIT_V(8); PG8_WAIT_L(0); PG8_BAR; PG8_MMA(1, 0, At, B0); PG8_MMA(1, 1, At, B1); PG8_BAR; PG8_SCHED;
            PG8_LDB(B0, 1, 0); PG8_LDB(B1, 1, 1); PG8_SCHED; PG8_LDA(At, 1, 0); PG8_STAGE(PG8_SA(0, 1), a2 + hstep, voffA);
            PG8_WAIT_V(8); PG8_WAIT_L(0); PG8_BAR; PG8_MMA(0, 0, At, B0); PG8_MMA(0, 1, At, B1); PG8_BAR; PG8_SCHED;
            PG8_LDA(At, 1, 1); PG8_STAGE(PG8_SB(1, 0), b3, voffB); PG8_STAGE(PG8_SB(1, 1), b3 + hstep, voffB); PG8_STAGE(PG8_SA(1, 0), a3, voffA);
            PG8_WAIT_V(8); PG8_WAIT_L(0); PG8_BAR; PG8_MMA(1, 0, At, B0); PG8_MMA(1, 1, At, B1); PG8_BAR; PG8_SCHED;
            } else {
            PG8_LDB(B0, 0, 0); PG8_SCHED; PG8_LDA(At, 0, 0); PG8_STAGE(PG8_SA(1, 1), a1 + hstep, voffA);
            PG8_WAIT_L(8); PG8_BAR; PG8_WAIT_L(0); PG8_MMA(0, 0, At, B0); PG8_BAR; PG8_SCHED;
            PG8_LDB(B1, 0, 1); PG8_STAGE(PG8_SB(0, 0), b2, voffB);
            PG8_BAR; PG8_WAIT_L(0); PG8_MMA(0, 1, At, B1); PG8_BAR;
            PG8_LDA(At, 0, 1); PG8_STAGE(PG8_SA(0, 0), a2, voffA);
            PG8_BAR; PG8_WAIT_L(0); PG8_MMA(1, 0, At, B0); PG8_BAR; PG8_SCHED;
            PG8_STAGE(PG8_SB(0, 1), b2 + hstep, voffB);
            PG8_WAIT_V(6); PG8_BAR; PG8_MMA(1, 1, At, B1); PG8_BAR;
            PG8_LDB(B0, 1, 0); PG8_SCHED; PG8_LDA(At, 1, 0); PG8_STAGE(PG8_SA(0, 1), a2 + hstep, voffA);
            PG8_WAIT_L(8); PG8_BAR; PG8_WAIT_L(0); PG8_MMA(0, 0, At, B0); PG8_BAR; PG8_SCHED;
            PG8_LDB(B1, 1, 1); PG8_STAGE(PG8_SB(1, 0), b3, voffB);
            PG8_BAR; PG8_WAIT_L(0); PG8_MMA(0, 1, At, B1); PG8_BAR;
            PG8_LDA(At, 1, 1); PG8_STAGE(PG8_SA(1, 0), a3, voffA);
            PG8_BAR; PG8_WAIT_L(0); PG8_MMA(1, 0, At, B0); PG8_BAR; PG8_SCHED;
            PG8_STAGE(PG8_SB(1, 1), b3 + hstep, voffB);
            PG8_WAIT_V(6); PG8_BAR; PG8_MMA(1, 1, At, B1); PG8_BAR;
            }
        }
        if constexpr (ALIGN_EPI) { if (wr == 0) PG8_BAR; }
        if constexpr (!Epi::AFTER_DRAIN) { E(acc, cur, wr, wc, fr, fq); S.done(cur); }
        if (!has_next) break;
#pragma unroll
        for (int a = 0; a < 2; ++a)
#pragma unroll
            for (int b = 0; b < 2; ++b)
#pragma unroll
                for (int m = 0; m < 4; ++m)
#pragma unroll
                    for (int n = 0; n < 2; ++n) acc[a][b][m][n] = (f32x4){0.f, 0.f, 0.f, 0.f};
        cur = nxt; cA = nA; cB = nB; ++ui;
        if constexpr (ALIGN_EPI) { if (wr == 1) PG8_BAR; }
    }
    PG8_WAIT_V(0);
    if constexpr (!ALIGN_EPI) { if (wr == 0) PG8_BAR; }
    PG8_BAR;
    if constexpr (Epi::AFTER_DRAIN) { E.fused(acc, cur, wr, wc, fr, fq, lds, wid, lane); S.done(cur); }
#undef PG8_SA
#undef PG8_SB
#undef PG8_STAGE
#undef PG8_LDA
#undef PG8_LDB
#undef PG8_MMA
#undef PG8_WAIT_V
#undef PG8_WAIT_L
#undef PG8_BAR
#undef PG8_SCHED
}
}
#define GAS __attribute__((address_space(1)))
#define LAS __attribute__((address_space(3)))
typedef unsigned short bf16;
typedef unsigned v4u __attribute__((ext_vector_type(4)));
typedef unsigned v2u __attribute__((ext_vector_type(2)));
typedef float f32x4 __attribute__((ext_vector_type(4)));
typedef short bf16x8 __attribute__((ext_vector_type(8)));
typedef GAS unsigned gu32;
#define RLX_AGENT __ATOMIC_RELAXED, __HIP_MEMORY_SCOPE_AGENT
#define LDS_WAIT() asm volatile("s_waitcnt lgkmcnt(0)" ::: "memory")
#define VM_WAIT() asm volatile("s_waitcnt vmcnt(0)" ::: "memory")

constexpr int NWAVES = 8;
constexpr int TOK = 8192, DM = 2048, DFF = 5632, NLAYER = 4;
constexpr int EIN_SRC = 5200, EIN_NP = 5376, OIN_SRC = 6160, OIN_NP = 6144;
constexpr float EPS = 1e-6f;
constexpr size_t MiB = 1u << 20;
constexpr size_t WS_CTL = 0, CTL_ZERO_BYTES = 1 * MiB;
constexpr size_t WS_MODP = 1 * MiB;
constexpr size_t WS_MODS = 3 * MiB;
constexpr size_t WS_COS = 4 * MiB, WS_SIN = 5 * MiB;
constexpr size_t WS_SSQ = 6 * MiB;
constexpr size_t WS_BA = 6 * MiB + 512 * 1024;
constexpr size_t WS_WGL = 7 * MiB;
constexpr size_t WS_WEIN = 8 * MiB;
constexpr size_t WS_WUQ = WS_WEIN + 42 * MiB;
constexpr size_t WS_WUKV = WS_WUQ + 3 * MiB;
constexpr size_t WS_WEOUT = WS_WUKV + 4 * MiB;
constexpr size_t WS_WOIN = WS_WEOUT + 16 * MiB;
constexpr size_t WS_WOOUT = WS_WOIN + 48 * MiB;
constexpr size_t WS_W13 = WS_WOOUT + 16 * MiB;
constexpr size_t WS_W2 = WS_W13 + 176 * MiB;
constexpr size_t WS_H = WS_W2 + 88 * MiB;
constexpr size_t WS_PROJ = WS_H + 32 * MiB;
constexpr size_t WS_QH = WS_PROJ + 96 * MiB;
constexpr size_t WS_KH = WS_QH + 24 * MiB;
constexpr size_t WS_VT = WS_KH + 24 * MiB;
constexpr size_t WS_MIX = WS_VT + 16 * MiB;
constexpr size_t WS_HID = WS_MIX + 32 * MiB;
constexpr size_t WS_OG = WS_HID + 88 * MiB;
constexpr size_t WS_SCR = WS_OG + 64 * MiB;
constexpr size_t WS_END = WS_SCR + 256 * MiB;
constexpr int CW_BAR = 4096;
constexpr int RING_BYTES = 131072, LDSCTL_OFF = RING_BYTES, LDS_BYTES = 147456, MISC_OFF = LDS_BYTES - 256;

__device__ __forceinline__ unsigned f2bf(float f) { unsigned u = __builtin_bit_cast(unsigned, f); return (u + 0x7fffu + ((u >> 16) & 1u)) >> 16; }
__device__ __forceinline__ unsigned pk2(float lo, float hi) { return f2bf(lo) | (f2bf(hi) << 16); }
__device__ __forceinline__ float bf2f(unsigned b) { return __builtin_bit_cast(float, (b & 0xffffu) << 16); }
__device__ __forceinline__ float bflo(unsigned w) { return __builtin_bit_cast(float, w << 16); }
__device__ __forceinline__ float bfhi(unsigned w) { return __builtin_bit_cast(float, w & 0xffff0000u); }
__device__ __forceinline__ float shx(float v, int k, int lane) { return __builtin_bit_cast(float, __builtin_amdgcn_ds_bpermute((lane ^ k) << 2, __builtin_bit_cast(int, v))); }
__device__ __forceinline__ float wave_sum(float v, int lane) {
#pragma unroll
    for (int o = 1; o < 64; o <<= 1) v += shx(v, o, lane);
    return v;
}
__device__ __forceinline__ float wave_max(float v, int lane) {
#pragma unroll
    for (int o = 1; o < 64; o <<= 1) v = fmaxf(v, shx(v, o, lane));
    return v;
}
__device__ __forceinline__ float silu_f(float a) { return a / (1.0f + __expf(-a)); }
__device__ __forceinline__ float softplus_f(float x) { return x > 20.f ? x : log1pf(__expf(x)); }

__host__ __device__ __forceinline__ int map_ein(int c) { if (c < 1024) return c; if (c < 1088) { const int i = c - 1024; return 5120 + (i < 32 ? 2 * i : 2 * (i - 32) + 1); } if (c < 5184) return c - 64; return c; }
__host__ __device__ __forceinline__ int map_uq(int c) { const int h = c / 192, d = c - h * 192; if (d < 128) return c; const int i = d - 128; return h * 192 + 128 + (i < 32 ? 2 * i : 2 * (i - 32) + 1); }
__host__ __device__ __forceinline__ int map_w13(int hc, int n) { const int pn = hc >> 7, rem = hc & 127, wc = rem >> 5, fq = (rem >> 3) & 3, bj = (rem >> 2) & 1, j = rem & 3; return 256 * pn + 128 * bj + 32 * wc + 8 * fq + 4 * n + j; }
enum { K_PLAIN = 0, K_EIN = 1, K_UQ = 2, K_W1 = 3, K_W3 = 4, K_OIN = 5 };

struct Args { const void* in[25]; float* out; unsigned char* ws; int ph_lo, ph_hi; };
struct Frame {
    LAS unsigned char* lds; unsigned char* ldsg; volatile LAS unsigned* MISC; gu32* ctl; unsigned char* ws;
    int wave, G, gw, NGW;
};
__device__ __forceinline__ int opaque_tid() { int t = threadIdx.x; asm volatile("" : "+v"(t)); return t; }
struct WDesc { const float* W; int ld, ncols, K; const float* kscale; int kind; bf16* D0; bf16* D1; int nitems; };

__device__ __forceinline__ WDesc get_wdesc(const Args& a, int mi) {
    WDesc d; d.kscale = nullptr; d.D1 = nullptr; d.kind = K_PLAIN;
    unsigned char* ws = a.ws;
    if (mi < 8) { const int i = mi >> 2, w = mi & 3;
        if (w == 0) { d.W = (const float*)a.in[6] + (size_t)i * DM * EIN_SRC; d.ld = EIN_SRC; d.ncols = EIN_SRC; d.K = DM; d.kind = K_EIN; d.D0 = (bf16*)(ws + WS_WEIN) + (size_t)i * EIN_NP * DM; }
        else if (w == 1) { d.W = (const float*)a.in[8] + (size_t)i * 512 * 1536; d.ld = 1536; d.ncols = 1536; d.K = 512; d.kind = K_UQ; d.kscale = (const float*)a.in[7] + i * 512; d.D0 = (bf16*)(ws + WS_WUQ) + (size_t)i * 1536 * 512; }
        else if (w == 2) { d.W = (const float*)a.in[10] + (size_t)i * 512 * 2048; d.ld = 2048; d.ncols = 2048; d.K = 512; d.kscale = (const float*)a.in[9] + i * 512; d.D0 = (bf16*)(ws + WS_WUKV) + (size_t)i * 2048 * 512; }
        else { d.W = (const float*)a.in[15] + (size_t)i * DM * DM; d.ld = DM; d.ncols = DM; d.K = DM; d.D0 = (bf16*)(ws + WS_WEOUT) + (size_t)i * DM * DM; }
    } else if (mi < 12) { const int i = (mi - 8) >> 1, w = (mi - 8) & 1;
        if (w == 0) { d.W = (const float*)a.in[16] + (size_t)i * DM * OIN_SRC; d.ld = OIN_SRC; d.ncols = OIN_SRC; d.K = DM; d.kind = K_OIN; d.D0 = (bf16*)(ws + WS_WOIN) + (size_t)i * OIN_NP * DM; d.D1 = (bf16*)(ws + WS_WGL) + (size_t)i * 16 * DM; }
        else { d.W = (const float*)a.in[20] + (size_t)i * DM * DM; d.ld = DM; d.ncols = DM; d.K = DM; d.D0 = (bf16*)(ws + WS_WOOUT) + (size_t)i * DM * DM; }
    } else { const int l = (mi - 12) / 3, w = (mi - 12) - 3 * l;
        if (w == 0) { d.W = (const float*)a.in[21] + (size_t)l * DM * DFF; d.ld = DFF; d.ncols = DFF; d.K = DM; d.kind = K_W1; d.D0 = (bf16*)(ws + WS_W13) + (size_t)l * 2 * DFF * DM; }
        else if (w == 1) { d.W = (const float*)a.in[22] + (size_t)l * DM * DFF; d.ld = DFF; d.ncols = DFF; d.K = DM; d.kind = K_W3; d.D0 = (bf16*)(ws + WS_W13) + (size_t)l * 2 * DFF * DM; }
        else { d.W = (const float*)a.in[23] + (size_t)l * DFF * DM; d.ld = DM; d.ncols = DM; d.K = DFF; d.D0 = (bf16*)(ws + WS_W2) + (size_t)l * DM * DFF; }
    }
    d.nitems = ((d.ncols + 63) / 64) * (d.K / 64);
    return d;
}
__device__ __forceinline__ bf16* wrow_ptr(const WDesc& d, int col) {
    int r = col;
    if (d.kind == K_EIN) r = map_ein(col); else if (d.kind == K_UQ) r = map_uq(col); else if (d.kind == K_W1) r = map_w13(col, 0); else if (d.kind == K_W3) r = map_w13(col, 1);
    else if (d.kind == K_OIN) { if (col >= OIN_NP) return d.D1 + (size_t)(col - OIN_NP) * d.K; }
    return d.D0 + (size_t)r * d.K;
}
__device__ __forceinline__ void p0_item(const WDesc& d, LAS float* scr, int item, int lane) {
    const int ncb = (d.ncols + 63) / 64, kb = item / ncb, cb = item - kb * ncb, k0 = 64 * kb, c0 = 64 * cb;
    const int cc = c0 + lane; const bool cv = cc < d.ncols;
    const float* src = d.W + (size_t)k0 * d.ld + cc;
    float v[64];
#pragma unroll
    for (int i = 0; i < 64; ++i) v[i] = cv ? src[(size_t)i * d.ld] : 0.f;
    if (d.kscale) {
#pragma unroll
        for (int i = 0; i < 64; ++i) v[i] *= d.kscale[k0 + i]; }
#pragma unroll
    for (int i = 0; i < 64; ++i) scr[i * 65 + lane] = v[i];
    LDS_WAIT(); asm volatile("" ::: "memory");
    const int c = lane & 7;
#pragma unroll
    for (int j = 0; j < 8; ++j) { const int n = (lane >> 3) + 8 * j; const int col = c0 + n;
        if (col < d.ncols) { const LAS float* s = scr + (8 * c) * 65 + n;
            v4u o; o.x = pk2(s[0 * 65], s[1 * 65]); o.y = pk2(s[2 * 65], s[3 * 65]); o.z = pk2(s[4 * 65], s[5 * 65]); o.w = pk2(s[6 * 65], s[7 * 65]);
            *(GAS v4u*)(wrow_ptr(d, col) + k0 + 8 * c) = o; } }
    LDS_WAIT(); asm volatile("" ::: "memory");
}
constexpr int ADA_TASKS = 8 * 24 * 8;
__device__ __forceinline__ void p0_prologue(Frame& F, const Args& a) {
    LAS float* scr = (LAS float*)(F.lds + F.wave * 16640);
    const int tid = opaque_tid(), lane = tid & 63;
    int g = F.gw;
    for (; g < ADA_TASKS; g += F.NGW) {
        const int m = g / 192, rem = g - m * 192, cg = rem >> 3, ks = rem & 7;
        const float* W = (const float*)a.in[4] + (size_t)m * DM * 6144 + (size_t)(ks * 256) * 6144 + cg * 256 + 4 * lane;
        const float* cvec = (const float*)a.in[1] + ks * 256;
        f32x4 acc = {0.f, 0.f, 0.f, 0.f};
#pragma unroll 8
        for (int k = 0; k < 256; ++k) { const float cv = cvec[k]; const float sc = cv / (1.0f + __expf(-cv)); const f32x4 w = *(const f32x4*)(W + (size_t)k * 6144); acc += w * sc; }
        *(f32x4*)((float*)(a.ws + WS_MODP) + ((size_t)(m * 8 + ks)) * 6144 + cg * 256 + 4 * lane) = acc;
    }
    g -= ADA_TASKS;
    { int mi = 0, mstart = 0; WDesc d = get_wdesc(a, 0);
      for (;;) { while (mi < 24 && g >= mstart + d.nitems) { mstart += d.nitems; ++mi; if (mi < 24) d = get_wdesc(a, mi); }
          if (mi >= 24) break; p0_item(d, scr, g - mstart, lane); g += F.NGW; } }
    { const size_t per = (size_t)(EIN_NP - EIN_SRC) * DM / 8;
      for (size_t i = (size_t)blockIdx.x * 512 + tid; i < 2 * per; i += (size_t)F.G * 512) { const size_t l = i / per, r = i - l * per;
          *(v4u*)((bf16*)(a.ws + WS_WEIN) + l * EIN_NP * DM + (size_t)EIN_SRC * DM + r * 8) = (v4u){0u, 0u, 0u, 0u}; } }
    { const int* pos = (const int*)a.in[2]; float* ct = (float*)(a.ws + WS_COS); float* st = (float*)(a.ws + WS_SIN);
      for (int i = blockIdx.x * 512 + tid; i < TOK * 32; i += F.G * 512) { const int t = i >> 5, j = i & 31;
          const float inv = powf(10000.0f, -(float)j / 32.0f); const float ang = (float)pos[t] * inv; ct[i] = cosf(ang); st[i] = sinf(ang); } }
}
template <int MODE> __device__ __forceinline__ void norm_phase(Frame& F, const Args& a, const float* xin, const float* g, int modidx, bf16* H, float* outf) {
    float* gs = (float*)F.ldsg; float* sh = gs + 2048;
    const int tid_l = opaque_tid(), lane_l = tid_l & 63;
    for (int c = tid_l; c < 2048; c += 512) {
        const float gv = g[c];
        if (MODE == 0) { const float* bp = (const float*)a.in[5] + (size_t)modidx * 6144; const float* pp = (const float*)(a.ws + WS_MODP) + (size_t)modidx * 8 * 6144;
            float shf = bp[c], scl = bp[2048 + c], gt = bp[4096 + c];
#pragma unroll
            for (int ks = 0; ks < 8; ++ks) { shf += pp[ks * 6144 + c]; scl += pp[ks * 6144 + 2048 + c]; gt += pp[ks * 6144 + 4096 + c]; }
            gs[c] = gv * (1.0f + scl); sh[c] = shf;
            if (blockIdx.x == 0) ((float*)(a.ws + WS_MODS))[modidx * 2048 + c] = gt;
        } else { gs[c] = gv; sh[c] = 0.f; }
    }
    __syncthreads();
    int gw_l = F.gw; asm volatile("" : "+s"(gw_l));
    for (int m = gw_l; m < TOK; m += F.NGW) {
        const f32x4* xr = (const f32x4*)(xin + (size_t)m * DM) + lane_l;
        f32x4 v[8]; float s = 0.f;
#pragma unroll
        for (int j = 0; j < 8; ++j) { v[j] = xr[64 * j]; s += (v[j][0] * v[j][0] + v[j][1] * v[j][1]) + (v[j][2] * v[j][2] + v[j][3] * v[j][3]); }
        const float r = rsqrtf(wave_sum(s, lane_l) * (1.0f / DM) + EPS);
#pragma unroll
        for (int j = 0; j < 8; ++j) { const int col = 4 * lane_l + 256 * j; const f32x4 gg = *(const f32x4*)(gs + col), ss = *(const f32x4*)(sh + col);
            const f32x4 o = v[j] * r * gg + ss;
            if (MODE == 0) { v2u w; w.x = pk2(o[0], o[1]); w.y = pk2(o[2], o[3]); *(v2u*)(H + (size_t)m * DM + col) = w; }
            else *(f32x4*)(outf + (size_t)m * DM + col) = o; }
    }
    __syncthreads();
}
template <int HD> __device__ __forceinline__ void gatenorm_phase(Frame& F, const float* OG, int ogld, const float* gnorm, const bf16* gatein, int gld, bf16* MIX, int mixoff) {
    constexpr int NC = (HD == 128) ? 1024 : 2048, PER = NC / 64, LPH = HD / PER;
    const int lane_l = opaque_tid() & 63; int gw_l = F.gw; asm volatile("" : "+s"(gw_l));
    for (int m = gw_l; m < TOK; m += F.NGW) {
        const float* orow = OG + (size_t)m * ogld + PER * lane_l; float v[PER]; float s = 0.f;
#pragma unroll
        for (int j = 0; j < PER; j += 4) { const f32x4 t = *(const f32x4*)(orow + j); v[j] = t[0]; v[j + 1] = t[1]; v[j + 2] = t[2]; v[j + 3] = t[3]; s += (t[0] * t[0] + t[1] * t[1]) + (t[2] * t[2] + t[3] * t[3]); }
#pragma unroll
        for (int o = 1; o < LPH; o <<= 1) s += shx(s, o, lane_l);
        const float r = rsqrtf(s * (1.0f / HD) + EPS);
        const int cbase = PER * lane_l, hc = cbase % HD;
        const bf16* zr = gatein + (size_t)m * gld + cbase; bf16* out = MIX + (size_t)m * DM + mixoff + cbase;
#pragma unroll
        for (int j = 0; j < PER; j += 8) { const v4u zz = *(const v4u*)(zr + j); float z[8] = {bflo(zz.x), bfhi(zz.x), bflo(zz.y), bfhi(zz.y), bflo(zz.z), bfhi(zz.z), bflo(zz.w), bfhi(zz.w)}; float o8[8];
#pragma unroll
            for (int e = 0; e < 8; ++e) o8[e] = v[j + e] * r * gnorm[hc + j + e] * silu_f(z[e]);
            v4u w; w.x = pk2(o8[0], o8[1]); w.y = pk2(o8[2], o8[3]); w.z = pk2(o8[4], o8[5]); w.w = pk2(o8[6], o8[7]); *(v4u*)(out + j) = w; }
    }
}
#define XB_TMO      128
#define XB_XCNT(j)  (256  + 64 * (j))
#define XB_XSUB(j)  (1280 + 64 * (j))
#define XB_XGEN(j)  (2304 + 64 * (j))
#define XB_TOP      3328
#define XB_TOPGEN   3392
#define XCD_BAR_WORDS 3456
#define XB_SPIN_CAP (1u << 18)

__device__ __forceinline__ unsigned xb_ld(unsigned* p)              { return __hip_atomic_load(p, __ATOMIC_RELAXED, __HIP_MEMORY_SCOPE_AGENT); }
__device__ __forceinline__ unsigned xb_add(unsigned* p, unsigned v) { return __hip_atomic_fetch_add(p, v, __ATOMIC_RELAXED, __HIP_MEMORY_SCOPE_AGENT); }
__device__ __forceinline__ unsigned xb_xcc_id() { return (unsigned)__builtin_amdgcn_s_getreg((3 << 11) | 20) & 0xFu; }
#define XB_SPIN(cond, bar) do { unsigned _sp = 0; while (cond) { __builtin_amdgcn_s_sleep(1); \
    if ((++_sp & 255u) == 0u) { if (xb_ld(&(bar)[XB_TMO])) break; if (_sp > XB_SPIN_CAP) { atomicAdd(&(bar)[XB_TMO], 1u); break; } } } } while (0)

struct XcdBarrier {
    unsigned* bar; unsigned x;
    volatile LAS unsigned* st;
};

__device__ __forceinline__ XcdBarrier xcd_barrier_post(unsigned* bar, volatile LAS unsigned* st) {
    XcdBarrier b; b.bar = bar; b.x = xb_xcc_id(); b.st = st;
    if (threadIdx.x == 0) (void)xb_add(&bar[XB_XCNT(b.x)], 1u);
    return b;
}
__device__ __forceinline__ void xcd_barrier_complete(unsigned* bar, unsigned x, unsigned& nloc, unsigned& nx) {
    const unsigned G = gridDim.x * gridDim.y * gridDim.z;
    unsigned sum, cnt, mine, sp = 0u;
    for (;;) {
        sum = 0u; cnt = 0u; mine = 0u;
#pragma unroll
        for (unsigned j = 0; j < 16; ++j) { const unsigned c = xb_ld(&bar[XB_XCNT(j)]); sum += c; cnt += (c > 0u) ? 1u : 0u; mine = (j == x) ? c : mine; }
        if (sum == G) break;
        __builtin_amdgcn_s_sleep(1);
        if ((++sp & 255u) == 0u) { if (xb_ld(&bar[XB_TMO])) break; if (sp > XB_SPIN_CAP) { atomicAdd(&bar[XB_TMO], 1u); break; } }
    }
    nloc = mine > 0u ? mine : 1u; nx = cnt > 0u ? cnt : 1u;
}

__device__ __forceinline__ void xcd_barrier(const XcdBarrier& b) {
    asm volatile("s_waitcnt vmcnt(0)" ::: "memory");
    __syncthreads();
    if (threadIdx.x == 0) {
        unsigned* bar = b.bar;
        __builtin_amdgcn_s_waitcnt(0);
        unsigned nloc = b.st[0], nx = b.st[1];
        if (nloc == 0u) { xcd_barrier_complete(bar, b.x, nloc, nx); b.st[0] = nloc; b.st[1] = nx; }
        const unsigned old = xb_add(&bar[XB_XSUB(b.x)], 1u);
        const unsigned gen = old / nloc;
        if (old + 1u == (gen + 1u) * nloc) {
            __builtin_amdgcn_fence(__ATOMIC_RELEASE, "agent");
            asm volatile("s_waitcnt vmcnt(0)" ::: "memory");
            const unsigned og = xb_add(&bar[XB_TOP], 1u);
            const unsigned tg = og / nx;
            if (og + 1u == (tg + 1u) * nx) xb_add(&bar[XB_TOPGEN], 1u);
            else XB_SPIN(xb_ld(&bar[XB_TOPGEN]) == tg, bar);
            __builtin_amdgcn_fence(__ATOMIC_ACQUIRE, "agent");
            xb_add(&bar[XB_XGEN(b.x)], 1u);
            asm volatile("s_waitcnt vmcnt(0)" ::: "memory");
        } else {
            XB_SPIN(xb_ld(&bar[XB_XGEN(b.x)]) == gen, bar);
            __builtin_amdgcn_fence(__ATOMIC_ACQUIRE, "agent");
            asm volatile("s_waitcnt vmcnt(0)" ::: "memory");
        }
    }
    __syncthreads();
}
typedef float f32x16 __attribute__((ext_vector_type(16)));
constexpr int AT_TILES_HEAD = 2112, AT_TILES = 8 * AT_TILES_HEAD;
constexpr int AT_KSTR = 400, AT_VSTR = 136;
constexpr int AT_KBYTES = 64 * AT_KSTR, AT_VBYTES = 128 * AT_VSTR, AT_BUF = AT_KBYTES + AT_VBYTES;
constexpr size_t AT_OPART_BYTES = (size_t)256 * 3 * 256 * 128 * 4;
constexpr int AT_NSLOW = 128, AT_WSLOW = 19, AT_WFAST = 25;
__device__ __forceinline__ int at_start(int c, int nb) { const long cw = (c < AT_NSLOW) ? (long)AT_WSLOW * c : (long)AT_WSLOW * AT_NSLOW + (long)AT_WFAST * (c - AT_NSLOW);
    const long W = (long)AT_WSLOW * AT_NSLOW + (long)AT_WFAST * (nb - AT_NSLOW); return (int)((cw * AT_TILES) / W); }
__device__ __forceinline__ void at_decode(int s, int& h, int& i, int& j) {
    h = s / AT_TILES_HEAD; const int r = s - h * AT_TILES_HEAD;
    int ii = (int)((sqrtf(1.0f + 2.0f * (float)r) - 1.0f) * 0.5f);
    if (ii < 0) ii = 0; if (ii > 31) ii = 31;
    while (ii < 31 && 2 * (ii + 1) * (ii + 2) <= r) ++ii;
    while (ii > 0 && 2 * ii * (ii + 1) > r) --ii;
    i = ii; j = r - 2 * ii * (ii + 1);
}
__device__ __forceinline__ int at_owner(int s, int nb) {
    int lo = 0, hi = nb - 1;
    while (lo < hi) { const int mid = (lo + hi + 1) >> 1; if (at_start(mid, nb) <= s) lo = mid; else hi = mid - 1; }
    return lo;
}
__device__ __forceinline__ float fexp2(float x) { return __builtin_amdgcn_exp2f(x); }
__device__ __forceinline__ unsigned cvtpk(float lo, float hi) { unsigned r; asm volatile("v_cvt_pk_bf16_f32 %0, %1, %2" : "=v"(r) : "v"(lo), "v"(hi)); return r; }

__device__ __forceinline__ void attn_phase(Frame& F, const bf16* QH, const bf16* KH, const bf16* VT, bf16* MIX, float* OPART, float* ML, int vcu, int b0) {
    const int nb = F.G - b0, c = vcu - b0;
    if (c < 0) return;
    const int tid = opaque_tid(), lane = tid & 63, w = F.wave, r = lane & 31, hh = lane >> 5;
    LAS unsigned char* lds = F.lds;
    const int kkey = tid >> 3, kc8 = tid & 7, vdv = tid >> 2, vc4 = tid & 3;
    const unsigned lK = (unsigned)(kkey * AT_KSTR + kc8 * 16), lV = (unsigned)(AT_KBYTES + vdv * AT_VSTR + vc4 * 16);
    const unsigned aK = (unsigned)(r * AT_KSTR + hh * 16), aV = (unsigned)(AT_KBYTES + r * AT_VSTR + hh * 8);
    int cur = at_start(c, nb); const int end = at_start(c + 1, nb);
    while (cur < end) {
        int h, i, j0; at_decode(cur, h, i, j0);
        const int n_i = 4 * (i + 1), j1 = (j0 + (end - cur) < n_i) ? j0 + (end - cur) : n_i, base = cur - j0;
        const bool whole = (j0 == 0) && (j1 == n_i);
        const int part = c - at_owner(base, nb);
        cur += j1 - j0;
        const int qrow = 256 * i + 32 * w + r;
        bf16x8 qf[12];
        { const bf16* qp = QH + ((size_t)h * TOK + qrow) * 192 + 8 * hh;
#pragma unroll
          for (int s = 0; s < 12; ++s) qf[s] = *(const bf16x8*)(qp + 16 * s); }
        f32x16 o[4];
#pragma unroll
        for (int d = 0; d < 4; ++d)
#pragma unroll
            for (int e = 0; e < 16; ++e) o[d][e] = 0.f;
        float m = -1e30f, l = 0.f;
        const bf16* gK = KH + ((size_t)h * TOK + kkey) * 192 + 8 * kc8;
        const bf16* gV = VT + ((size_t)h * 128 + vdv) * TOK + 8 * vc4;
        v4u kreg[3], vreg[2];
#define AT_LOAD(j) do { const bf16* pk_ = gK + (size_t)(j) * (64 * 192); const bf16* pv_ = gV + (size_t)(j) * 64; \
        kreg[0] = *(const v4u*)(pk_); kreg[1] = *(const v4u*)(pk_ + 64); kreg[2] = *(const v4u*)(pk_ + 128); vreg[0] = *(const v4u*)(pv_); vreg[1] = *(const v4u*)(pv_ + 32); } while (0)
#define AT_STORE(buf) do { LAS unsigned char* b_ = lds + (buf) * AT_BUF; \
        *(LAS v4u*)(b_ + lK) = kreg[0]; *(LAS v4u*)(b_ + lK + 128) = kreg[1]; *(LAS v4u*)(b_ + lK + 256) = kreg[2]; \
        *(LAS v2u*)(b_ + lV) = (v2u){vreg[0].x, vreg[0].y}; *(LAS v2u*)(b_ + lV + 8) = (v2u){vreg[0].z, vreg[0].w}; \
        *(LAS v2u*)(b_ + lV + 64) = (v2u){vreg[1].x, vreg[1].y}; *(LAS v2u*)(b_ + lV + 72) = (v2u){vreg[1].z, vreg[1].w}; } while (0)
        __syncthreads();
        AT_LOAD(j0); AT_STORE(0);
        __syncthreads();
        int cb = 0;
        for (int j = j0; j < j1; ++j) {
            if (j + 1 < j1) AT_LOAD(j + 1);
            const bool diag = (j >= 4 * i);
            if (!(diag && 64 * j > 256 * i + 32 * w + 31)) {
                LAS unsigned char* kb = lds + cb * AT_BUF;
                f32x16 s0, s1;
#pragma unroll
                for (int e = 0; e < 16; ++e) { s0[e] = 0.f; s1[e] = 0.f; }
#pragma unroll
                for (int s = 0; s < 12; ++s) {
                    const bf16x8 a0 = *(const LAS bf16x8*)(kb + aK + s * 32), a1 = *(const LAS bf16x8*)(kb + aK + 32 * AT_KSTR + s * 32);
                    s0 = __builtin_amdgcn_mfma_f32_32x32x16_bf16(a0, qf[s], s0, 0, 0, 0);
                    s1 = __builtin_amdgcn_mfma_f32_32x32x16_bf16(a1, qf[s], s1, 0, 0, 0);
                }
                if (diag) {
                    const int kq = 64 * j + 4 * hh - qrow;
#pragma unroll
                    for (int e = 0; e < 16; ++e) { const int ko = (e & 3) + 8 * (e >> 2);
                        if (kq + ko > 0) s0[e] = -INFINITY; if (kq + ko + 32 > 0) s1[e] = -INFINITY; }
                }
                float mx = fmaxf(s0[0], s1[0]);
#pragma unroll
                for (int e = 1; e < 16; ++e) mx = fmaxf(mx, fmaxf(s0[e], s1[e]));
                mx = fmaxf(mx, shx(mx, 32, lane));
                const float mn = fmaxf(m, mx), alpha = fexp2(m - mn); m = mn;
                float ps = 0.f;
#pragma unroll
                for (int e = 0; e < 16; ++e) { s0[e] = fexp2(s0[e] - mn); s1[e] = fexp2(s1[e] - mn); ps += s0[e] + s1[e]; }
                l = l * alpha + ps;
#pragma unroll
                for (int d = 0; d < 4; ++d)
#pragma unroll
                    for (int e = 0; e < 16; ++e) o[d][e] *= alpha;
                bf16x8 pf[4];
                { v4u t;
                  t.x = cvtpk(s0[0], s0[1]); t.y = cvtpk(s0[2], s0[3]); t.z = cvtpk(s0[4], s0[5]); t.w = cvtpk(s0[6], s0[7]); pf[0] = __builtin_bit_cast(bf16x8, t);
                  t.x = cvtpk(s0[8], s0[9]); t.y = cvtpk(s0[10], s0[11]); t.z = cvtpk(s0[12], s0[13]); t.w = cvtpk(s0[14], s0[15]); pf[1] = __builtin_bit_cast(bf16x8, t);
                  t.x = cvtpk(s1[0], s1[1]); t.y = cvtpk(s1[2], s1[3]); t.z = cvtpk(s1[4], s1[5]); t.w = cvtpk(s1[6], s1[7]); pf[2] = __builtin_bit_cast(bf16x8, t);
                  t.x = cvtpk(s1[8], s1[9]); t.y = cvtpk(s1[10], s1[11]); t.z = cvtpk(s1[12], s1[13]); t.w = cvtpk(s1[14], s1[15]); pf[3] = __builtin_bit_cast(bf16x8, t); }
#pragma unroll
                for (int d = 0; d < 4; ++d)
#pragma unroll
                    for (int ks = 0; ks < 4; ++ks) {
                        const v2u lo = *(const LAS v2u*)(kb + aV + d * 32 * AT_VSTR + ks * 32), hi = *(const LAS v2u*)(kb + aV + d * 32 * AT_VSTR + ks * 32 + 16);
                        const v4u av = {lo.x, lo.y, hi.x, hi.y};
                        o[d] = __builtin_amdgcn_mfma_f32_32x32x16_bf16(__builtin_bit_cast(bf16x8, av), pf[ks], o[d], 0, 0, 0);
                    }
            }
            if (j + 1 < j1) AT_STORE(cb ^ 1);
            __syncthreads();
            cb ^= 1;
        }
#undef AT_LOAD
#undef AT_STORE
        const float lt = l + shx(l, 32, lane);
        if (whole) {
            const float inv = 1.0f / lt;
            bf16* op = MIX + (size_t)qrow * DM + h * 128 + 4 * hh;
#pragma unroll
            for (int d = 0; d < 4; ++d)
#pragma unroll
                for (int g4 = 0; g4 < 4; ++g4) { v2u wv; wv.x = pk2(o[d][4 * g4] * inv, o[d][4 * g4 + 1] * inv); wv.y = pk2(o[d][4 * g4 + 2] * inv, o[d][4 * g4 + 3] * inv);
                    *(v2u*)(op + 32 * d + 8 * g4) = wv; }
        } else {
            const size_t slot = (size_t)(h * 32 + i) * 3 + part;
            float* op = OPART + (slot * 256 + 32 * w + r) * 128 + 4 * hh;
#pragma unroll
            for (int d = 0; d < 4; ++d)
#pragma unroll
                for (int g4 = 0; g4 < 4; ++g4) *(f32x4*)(op + 32 * d + 8 * g4) = (f32x4){o[d][4 * g4], o[d][4 * g4 + 1], o[d][4 * g4 + 2], o[d][4 * g4 + 3]};
            if (hh == 0) { float* mp = ML + (slot * 256 + 32 * w + r) * 2; mp[0] = m; mp[1] = lt; }
        }
    }
    __syncthreads();
}
__device__ __forceinline__ void attn_merge_phase(Frame& F, const float* OPART, const float* ML, bf16* MIX, int b0) {
    const int nb = F.G - b0, lane = opaque_tid() & 63;
    int gw_l = F.gw; asm volatile("" : "+s"(gw_l));
    for (int task = gw_l; task < 256 * 256; task += F.NGW) {
        const int b = task >> 8, row = task & 255, h = b >> 5, i = b & 31;
        const int base = h * AT_TILES_HEAD + 2 * i * (i + 1), n_i = 4 * (i + 1);
        const int clo = at_owner(base, nb), chi = at_owner(base + n_i - 1, nb), np = chi - clo + 1;
        if (np <= 1) continue;
        float mk[3], lk[3]; float M = -1e30f;
#pragma unroll
        for (int k = 0; k < 3; ++k) { mk[k] = -1e30f; lk[k] = 0.f; if (k < np) { const float* mp = ML + (((size_t)b * 3 + k) * 256 + row) * 2; mk[k] = mp[0]; lk[k] = mp[1]; } M = fmaxf(M, mk[k]); }
        float L = 0.f, o0 = 0.f, o1 = 0.f;
#pragma unroll
        for (int k = 0; k < 3; ++k) if (k < np) { const float wk = fexp2(mk[k] - M); L += wk * lk[k]; const float* op = OPART + (((size_t)b * 3 + k) * 256 + row) * 128 + 2 * lane; o0 += wk * op[0]; o1 += wk * op[1]; }
        const float inv = 1.0f / L;
        *(unsigned*)(MIX + (size_t)(256 * i + row) * DM + h * 128 + 2 * lane) = pk2(o0 * inv, o1 * inv);
    }
}
constexpr int GD_WP = 0, GD_QD = 16384, GD_AI = 32768, GD_KDT = 40960, GD_U = 57344, GD_EGL = 90112, GD_UNIT = 90368;
constexpr size_t GD_OPS_BYTES = (size_t)1024 * GD_UNIT;
__host__ __device__ __forceinline__ int perm_pos(int o) { return (o < 16) ? 8 * (o >> 2) + (o & 3) : 8 * ((o - 16) >> 2) + 4 + (o & 3); }
constexpr int GP_XF = 0, GP_KF = 32768, GP_VF = 65536, GP_QB = 98304, GP_KB = 115712, GP_G = 133120;
constexpr int GP_BSTR = 272, GP_LSTR = 68;
typedef float f32x4v __attribute__((ext_vector_type(4)));

__device__ __forceinline__ void gdn_prep_phase(Frame& F, const bf16* QKV, const float* BA, const float* convw, const float* a_log, const float* dt_bias, unsigned char* OPS) {
    const int tid = opaque_tid(), lane = tid & 63, w = F.wave;
    LAS unsigned char* lds = F.lds;
    LAS float* XF = (LAS float*)(lds + GP_XF); LAS float* KF = (LAS float*)(lds + GP_KF); LAS float* VF = (LAS float*)(lds + GP_VF);
    LAS float* LM = (LAS float*)(lds + GP_XF);
    LAS float* gbeta = (LAS float*)(lds + GP_G); LAS float* ggc = gbeta + 64; LAS float* gegc = gbeta + 128;
    for (int unit = blockIdx.x; unit < 1024; unit += F.G) {
        const int h = unit & 7, n = unit >> 3, t0 = 64 * n;
        unsigned char* ops = OPS + (size_t)(h * 128 + n) * GD_UNIT;
        if (tid < 384) {
            const int seg = tid >> 7, rh = (tid >> 6) & 1, cp = tid & 63, ch = seg * 1024 + h * 128 + 2 * cp;
            float w0[4], w1[4];
#pragma unroll
            for (int j = 0; j < 4; ++j) { w0[j] = convw[j * 3072 + ch]; w1[j] = convw[j * 3072 + ch + 1]; }
            float a0[3], a1[3];
#pragma unroll
            for (int j = 0; j < 3; ++j) { const int tt = t0 + 32 * rh - 3 + j; unsigned v = 0u; if (tt >= 0) v = *(const unsigned*)(QKV + (size_t)tt * 3072 + ch); a0[j] = bflo(v); a1[j] = bfhi(v); }
            LAS float* dst = (seg == 0 ? XF : seg == 1 ? KF : VF) + 2 * cp;
#pragma unroll 4
            for (int t = 0; t < 32; ++t) { const int tt = t0 + 32 * rh + t; const unsigned v = *(const unsigned*)(QKV + (size_t)tt * 3072 + ch); const float c0 = bflo(v), c1 = bfhi(v);
                const float y0 = w0[0] * a0[0] + w0[1] * a0[1] + w0[2] * a0[2] + w0[3] * c0, y1 = w1[0] * a1[0] + w1[1] * a1[1] + w1[2] * a1[2] + w1[3] * c1;
                a0[0] = a0[1]; a0[1] = a0[2]; a0[2] = c0; a1[0] = a1[1]; a1[1] = a1[2]; a1[2] = c1;
                dst[(32 * rh + t) * 128] = silu_f(y0); dst[(32 * rh + t) * 128 + 1] = silu_f(y1); }
        }
        __syncthreads();
        for (int rr = 0; rr < 16; ++rr) { const int row = w * 16 + rr;
            const bool isk = row >= 64; const int t = row & 63; LAS float* src = (isk ? KF : XF) + t * 128 + 2 * lane;
            const float v0 = src[0], v1 = src[1]; const float rn = rsqrtf(wave_sum(v0 * v0 + v1 * v1, lane) + EPS);
            if (isk) { src[0] = v0 * rn; src[1] = v1 * rn; *(LAS unsigned*)(lds + GP_KB + t * GP_BSTR + 4 * lane) = pk2(v0 * rn, v1 * rn); }
            else *(LAS unsigned*)(lds + GP_QB + t * GP_BSTR + 4 * lane) = pk2(v0 * rn * 0.08838834764831845f, v1 * rn * 0.08838834764831845f); }
        if (w == 0) {
            const float beta = 1.0f / (1.0f + __expf(-BA[(size_t)(t0 + lane) * 16 + h]));
            const float g = -__expf(a_log[h]) * softplus_f(BA[(size_t)(t0 + lane) * 16 + 8 + h] + dt_bias[h]);
            float gc = g;
#pragma unroll
            for (int d = 1; d < 64; d <<= 1) { const float up = __builtin_bit_cast(float, __builtin_amdgcn_ds_bpermute(((lane - d) & 63) << 2, __builtin_bit_cast(int, gc))); if (lane >= d) gc += up; }
            gbeta[lane] = beta; ggc[lane] = gc; gegc[lane] = __expf(gc); gbeta[192 + lane] = beta * __expf(gc);
        }
        __syncthreads();
        {   const int fr = lane & 15, fg = lane >> 4;
#pragma unroll 1
            for (int tt = 0; tt < 4; ++tt) { const int task = w * 4 + tt, isA = task >> 4, mi = (task >> 2) & 3, nj = task & 3;
                if (mi >= nj) {
                    f32x4v acc = {0.f, 0.f, 0.f, 0.f};
                    const LAS unsigned char* ab = lds + (isA ? GP_QB : GP_KB) + (16 * mi + fr) * GP_BSTR + 16 * fg; const LAS unsigned char* bb = lds + GP_KB + (16 * nj + fr) * GP_BSTR + 16 * fg;
#pragma unroll
                    for (int s = 0; s < 4; ++s) acc = __builtin_amdgcn_mfma_f32_16x16x32_bf16(*(const LAS bf16x8*)(ab + 64 * s), *(const LAS bf16x8*)(bb + 64 * s), acc, 0, 0, 0);
                    const int j = 16 * nj + fr; const float gj = ggc[j];
#pragma unroll
                    for (int e = 0; e < 4; ++e) { const int i = 16 * mi + 4 * fg + e; const float dec = __expf(ggc[i] - gj);
                        if (isA) { const float v = (i >= j) ? acc[e] * dec : 0.f; *(bf16*)(ops + GD_AI + i * 128 + ((j & 32) + perm_pos(j & 31)) * 2) = (bf16)f2bf(v); }
                        else { LM[i * GP_LSTR + j] = (i > j) ? acc[e] * dec * gbeta[i] : 0.f; } }
                } else if (isA) {
                    const int j = 16 * nj + fr;
#pragma unroll
                    for (int e = 0; e < 4; ++e) { const int i = 16 * mi + 4 * fg + e; *(bf16*)(ops + GD_AI + i * 128 + ((j & 32) + perm_pos(j & 31)) * 2) = (bf16)0; }
                }
            }
        }
        __syncthreads();
        if (tid < 256) {
            const int c = tid, isw = c >> 7, cc = c & 127;
            const LAS float* bsrc = (isw ? KF : VF) + cc; const LAS float* facp = gbeta + (isw ? 192 : 0);
            float x[64];
#pragma unroll
            for (int i = 0; i < 64; ++i) x[i] = 0.f;
#pragma unroll
            for (int i = 0; i < 64; ++i) {
                float acc = bsrc[i * 128] * facp[i];
#pragma unroll
                for (int j4 = 0; j4 < 16; ++j4) if (4 * j4 < i) { const f32x4v l4 = *(const LAS f32x4v*)(LM + i * GP_LSTR + 4 * j4);
                    acc -= l4[0] * x[4 * j4]; acc -= l4[1] * x[4 * j4 + 1]; acc -= l4[2] * x[4 * j4 + 2]; acc -= l4[3] * x[4 * j4 + 3]; }
                x[i] = acc;
                __builtin_amdgcn_sched_barrier(0);
            }
            if (isw) {
                bf16* wp = (bf16*)(ops + GD_WP) + (cc & 96) + perm_pos(cc & 31);
#pragma unroll
                for (int i = 0; i < 64; ++i) wp[i * 128] = (bf16)f2bf(x[i]);
            } else {
                float* up = (float*)(ops + GD_U) + (size_t)(cc >> 4) * 1024 + (cc & 15) * 4;
#pragma unroll
                for (int i = 0; i < 64; ++i) up[(i >> 4) * 256 + ((i & 15) >> 2) * 64 + (i & 3)] = x[i];
            }
        } else {
            const int u2 = tid - 256;
            { const int t = u2 >> 2, db = u2 & 3; const float eg = gegc[t]; const LAS unsigned* qs = (const LAS unsigned*)(lds + GP_QB + t * GP_BSTR + 64 * db);
              float v[32];
#pragma unroll
              for (int e = 0; e < 16; ++e) { const unsigned wv = qs[e]; v[2 * e] = bflo(wv) * eg; v[2 * e + 1] = bfhi(wv) * eg; }
              v4u o4[4];
#pragma unroll
              for (int g = 0; g < 4; ++g) { o4[g].x = pk2(v[4 * g], v[4 * g + 1]); o4[g].y = pk2(v[4 * g + 2], v[4 * g + 3]); o4[g].z = pk2(v[16 + 4 * g], v[16 + 4 * g + 1]); o4[g].w = pk2(v[16 + 4 * g + 2], v[16 + 4 * g + 3]); }
              v4u* dst = (v4u*)(ops + GD_QD + t * 256 + 64 * db);
#pragma unroll
              for (int g = 0; g < 4; ++g) dst[g] = o4[g]; }
            { const int d = u2 >> 1, tb = u2 & 1; const float gl = ggc[63];
              float v[32];
#pragma unroll
              for (int e = 0; e < 32; ++e) { const int t = 32 * tb + e; v[e] = KF[t * 128 + d] * __expf(gl - ggc[t]); }
              v4u* dst = (v4u*)(ops + GD_KDT + d * 128 + 64 * tb);
#pragma unroll
              for (int g = 0; g < 4; ++g) { v4u o4; o4.x = pk2(v[4 * g], v[4 * g + 1]); o4.y = pk2(v[4 * g + 2], v[4 * g + 3]); o4.z = pk2(v[16 + 4 * g], v[16 + 4 * g + 1]); o4.w = pk2(v[16 + 4 * g + 2], v[16 + 4 * g + 3]); dst[g] = o4; } }
            if (u2 == 0) *(float*)(ops + GD_EGL) = gegc[63];
        }
        __syncthreads();
    }
}

constexpr int GS_WP = 0, GS_QD = 17408, GS_AI = 34816, GS_KDT = 44032, GS_BUF = 62464, GS_PART = 2 * GS_BUF;
constexpr size_t GD_QG_BYTES = (size_t)8 * 16 * 128 * 128 * 4, GD_PG_BYTES = (size_t)8 * 16 * 128 * 128 * 2;
template <int MODE> __device__ __forceinline__ void gdn_scan_phase(Frame& F, const unsigned char* OPS, float* QG, bf16* PG, const bf16* Z, const float* gnorm, bf16* MIX, int h, int g) {
    const int tid = opaque_tid(), lane = tid & 63, w = F.wave, fr = lane & 15, fg = lane >> 4;
    LAS unsigned char* lds = F.lds;
    const unsigned gofA = (unsigned)tid * 16u, lofA = (unsigned)((tid >> 4) * 272 + (tid & 15) * 16), lofB = (unsigned)((tid >> 3) * 144 + (tid & 7) * 16);
    f32x4v Sf[8];
#pragma unroll
    for (int t = 0; t < 8; ++t)
#pragma unroll
        for (int e = 0; e < 4; ++e) Sf[t][e] = (MODE == 1 && (16 * t + 4 * fg + e) == (16 * w + fr)) ? 1.f : 0.f;
    if (MODE == 2) {
        for (int gp = 0; gp < g; ++gp) {
            bf16x8 Sb[4];
#pragma unroll
            for (int s = 0; s < 4; ++s) { v4u t; t.x = cvtpk(Sf[2 * s][0], Sf[2 * s][1]); t.y = cvtpk(Sf[2 * s][2], Sf[2 * s][3]); t.z = cvtpk(Sf[2 * s + 1][0], Sf[2 * s + 1][1]); t.w = cvtpk(Sf[2 * s + 1][2], Sf[2 * s + 1][3]); Sb[s] = __builtin_bit_cast(bf16x8, t); }
            const float* qp = QG + ((size_t)((h * 16 + gp) * 8 + w) * 8) * 256 + lane * 4; const bf16* pp = PG + ((size_t)(h * 16 + gp) * 128 + fr) * 128 + 8 * fg;
#pragma unroll
            for (int t = 0; t < 8; ++t) { f32x4v a = *(const f32x4v*)(qp + t * 256);
#pragma unroll
                for (int s = 0; s < 4; ++s) a = __builtin_amdgcn_mfma_f32_16x16x32_bf16(*(const bf16x8*)(pp + (size_t)t * 16 * 128 + 32 * s), Sb[s], a, 0, 0, 0);
                Sf[t] = a; }
        }
    }
    v4u pre[7]; f32x4v upre[4]; float eglp = 1.f; unsigned zpre[16];
#define GS_LOAD(n) do { const unsigned char* o_ = OPS + (size_t)(h * 128 + (n)) * GD_UNIT; \
        pre[0] = *(const v4u*)(o_ + GD_WP + gofA); pre[1] = *(const v4u*)(o_ + GD_WP + gofA + 8192); pre[5] = *(const v4u*)(o_ + GD_KDT + gofA); pre[6] = *(const v4u*)(o_ + GD_KDT + gofA + 8192); \
        if (MODE == 2) { pre[2] = *(const v4u*)(o_ + GD_QD + gofA); pre[3] = *(const v4u*)(o_ + GD_QD + gofA + 8192); pre[4] = *(const v4u*)(o_ + GD_AI + gofA); \
            _Pragma("unroll") for (int m_ = 0; m_ < 4; ++m_) _Pragma("unroll") for (int e_ = 0; e_ < 4; ++e_) zpre[4 * m_ + e_] = Z[(size_t)(64 * (n) + 16 * m_ + 4 * fg + e_) * 1024 + h * 128 + 16 * w + fr]; } \
        if (MODE != 1) { _Pragma("unroll") for (int m_ = 0; m_ < 4; ++m_) upre[m_] = *(const f32x4v*)(o_ + GD_U + ((size_t)(w * 4 + m_) * 64 + lane) * 16); } \
        eglp = *(const float*)(o_ + GD_EGL); } while (0)
#define GS_STORE(buf) do { LAS unsigned char* b_ = lds + (buf) * GS_BUF; \
        *(LAS v4u*)(b_ + GS_WP + lofA) = pre[0]; *(LAS v4u*)(b_ + GS_WP + lofA + 32 * 272) = pre[1]; *(LAS v4u*)(b_ + GS_KDT + lofB) = pre[5]; *(LAS v4u*)(b_ + GS_KDT + lofB + 64 * 144) = pre[6]; \
        if (MODE == 2) { *(LAS v4u*)(b_ + GS_QD + lofA) = pre[2]; *(LAS v4u*)(b_ + GS_QD + lofA + 32 * 272) = pre[3]; *(LAS v4u*)(b_ + GS_AI + lofB) = pre[4]; } } while (0)
    const int n0 = 8 * g;
    GS_LOAD(n0); GS_STORE(0);
    f32x4v ucur[4]; float egl = eglp; unsigned zcur[16];
#pragma unroll
    for (int m = 0; m < 4; ++m) ucur[m] = (MODE == 1) ? (f32x4v){0.f, 0.f, 0.f, 0.f} : upre[m];
    if (MODE == 2) {
#pragma unroll
        for (int e = 0; e < 16; ++e) zcur[e] = zpre[e]; }
    __syncthreads();
    const unsigned aA = (unsigned)(fr * 272 + fg * 16), aB = (unsigned)(fr * 144 + fg * 16);
    const float gn = (MODE == 2) ? gnorm[16 * w + fr] : 0.f;
    int cb = 0;
    for (int nn = 0; nn < 8; ++nn) {
        const int n = n0 + nn;
        if (nn + 1 < 8) GS_LOAD(n + 1);
        LAS unsigned char* b = lds + cb * GS_BUF;
        bf16x8 Sb[4];
#pragma unroll
        for (int s = 0; s < 4; ++s) { v4u t; t.x = cvtpk(Sf[2 * s][0], Sf[2 * s][1]); t.y = cvtpk(Sf[2 * s][2], Sf[2 * s][3]); t.z = cvtpk(Sf[2 * s + 1][0], Sf[2 * s + 1][1]); t.w = cvtpk(Sf[2 * s + 1][2], Sf[2 * s + 1][3]); Sb[s] = __builtin_bit_cast(bf16x8, t); }
        f32x4v vn[4], oo[4];
#pragma unroll
        for (int m = 0; m < 4; ++m) { f32x4v a1 = {0.f, 0.f, 0.f, 0.f}, a2 = {0.f, 0.f, 0.f, 0.f};
#pragma unroll
            for (int s = 0; s < 4; ++s) { a1 = __builtin_amdgcn_mfma_f32_16x16x32_bf16(*(const LAS bf16x8*)(b + GS_WP + aA + m * 16 * 272 + s * 64), Sb[s], a1, 0, 0, 0);
                if (MODE == 2) a2 = __builtin_amdgcn_mfma_f32_16x16x32_bf16(*(const LAS bf16x8*)(b + GS_QD + aA + m * 16 * 272 + s * 64), Sb[s], a2, 0, 0, 0); }
            vn[m] = ucur[m] - a1; oo[m] = a2; }
        bf16x8 Vb[2];
#pragma unroll
        for (int s = 0; s < 2; ++s) { v4u t; t.x = cvtpk(vn[2 * s][0], vn[2 * s][1]); t.y = cvtpk(vn[2 * s][2], vn[2 * s][3]); t.z = cvtpk(vn[2 * s + 1][0], vn[2 * s + 1][1]); t.w = cvtpk(vn[2 * s + 1][2], vn[2 * s + 1][3]); Vb[s] = __builtin_bit_cast(bf16x8, t); }
        if (MODE == 2) {
#pragma unroll
            for (int m = 0; m < 4; ++m)
#pragma unroll
                for (int s = 0; s < 2; ++s) oo[m] = __builtin_amdgcn_mfma_f32_16x16x32_bf16(*(const LAS bf16x8*)(b + GS_AI + aB + m * 16 * 144 + s * 64), Vb[s], oo[m], 0, 0, 0);
        }
#pragma unroll
        for (int t = 0; t < 8; ++t) { f32x4v a = Sf[t] * egl;
#pragma unroll
            for (int s = 0; s < 2; ++s) a = __builtin_amdgcn_mfma_f32_16x16x32_bf16(*(const LAS bf16x8*)(b + GS_KDT + aB + t * 16 * 144 + s * 64), Vb[s], a, 0, 0, 0);
            Sf[t] = a; }
        LAS float* part = (LAS float*)(lds + GS_PART + (nn & 1) * 2048);
        if (MODE == 2) {
#pragma unroll
            for (int m = 0; m < 4; ++m)
#pragma unroll
                for (int e = 0; e < 4; ++e) { float q = oo[m][e] * oo[m][e]; q += shx(q, 1, lane); q += shx(q, 2, lane); q += shx(q, 4, lane); q += shx(q, 8, lane); if (fr == 0) part[(16 * m + 4 * fg + e) * 8 + w] = q; }
        }
        if (nn + 1 < 8) GS_STORE(cb ^ 1);
        __syncthreads();
        if (MODE == 2) {
#pragma unroll
            for (int m = 0; m < 4; ++m)
#pragma unroll
                for (int e = 0; e < 4; ++e) { const int t = 16 * m + 4 * fg + e; const f32x4v p0 = *(const LAS f32x4v*)(part + t * 8), p1 = *(const LAS f32x4v*)(part + t * 8 + 4);
                    const float tot = ((p0[0] + p0[1]) + (p0[2] + p0[3])) + ((p1[0] + p1[1]) + (p1[2] + p1[3])); const float rn = rsqrtf(tot * (1.0f / 128.0f) + EPS);
                    const size_t row = (size_t)(64 * n + t); const float z = bf2f(zcur[4 * m + e]);
                    MIX[row * DM + 1024 + h * 128 + 16 * w + fr] = (bf16)f2bf(oo[m][e] * rn * gn * silu_f(z)); }
        }
        if (nn + 1 < 8) {
#pragma unroll
            for (int m = 0; m < 4; ++m) ucur[m] = (MODE == 1) ? (f32x4v){0.f, 0.f, 0.f, 0.f} : upre[m];
            if (MODE == 2) {
#pragma unroll
                for (int e = 0; e < 16; ++e) zcur[e] = zpre[e]; }
            egl = eglp; }
        cb ^= 1;
    }
#undef GS_LOAD
#undef GS_STORE
    if (MODE == 0) { float* qp = QG + ((size_t)((h * 16 + g) * 8 + w) * 8) * 256 + lane * 4;
#pragma unroll
        for (int t = 0; t < 8; ++t) *(f32x4v*)(qp + t * 256) = Sf[t]; }
    if (MODE == 1) { const int col = 16 * w + fr; bf16* pp = PG + ((size_t)(h * 16 + g) * 128) * 128 + (col & 96) + perm_pos(col & 31);
#pragma unroll
        for (int t = 0; t < 8; ++t)
#pragma unroll
            for (int e = 0; e < 4; ++e) pp[(size_t)(16 * t + 4 * fg + e) * 128] = (bf16)f2bf(Sf[t][e]); }
    __syncthreads();
}
constexpr int GL_QP = 0, GL_AI = 32768, GL_KDT = 40960, GL_VT = 73728, GL_DL = 139264, GL_UNIT = 140288;
constexpr size_t GL_OPS_BYTES = (size_t)512 * GL_UNIT;
constexpr int GLP_GKL = 0, GLP_BC = 8192, GLP_QPB = 73728, GLP_KPB = 107520, GLP_STR = 528;
constexpr int NGRP = 16, GCH = 8;

__device__ __forceinline__ void gla_prep_phase(Frame& F, const bf16* H, const bf16* WGL, const float* w2, const float* b2, const bf16* GQ, const bf16* GK, const bf16* GV, unsigned char* OPS) {
    const int tid = opaque_tid(), lane = tid & 63, w = F.wave, fr = lane & 15, fg = lane >> 4;
    LAS unsigned char* lds = F.lds;
    LAS float* GKL = (LAS float*)(lds + GLP_GKL); LAS float* BC = (LAS float*)(lds + GLP_BC);
    for (int unit = blockIdx.x; unit < 512; unit += F.G) {
        const int h = unit & 3, n = unit >> 2, t0 = 64 * n;
        unsigned char* ops = OPS + (size_t)(h * 128 + n) * GL_UNIT;
        { const int m = w & 3, kh = w >> 2; f32x4v acc = {0.f, 0.f, 0.f, 0.f};
          const bf16* ap = H + (size_t)(t0 + 16 * m + fr) * DM + 1024 * kh + 8 * fg; const bf16* bp = WGL + (size_t)fr * DM + 1024 * kh + 8 * fg;
#pragma unroll 8
          for (int s = 0; s < 32; ++s) acc = __builtin_amdgcn_mfma_f32_16x16x32_bf16(*(const bf16x8*)(ap + 32 * s), *(const bf16x8*)(bp + 32 * s), acc, 0, 0, 0);
#pragma unroll
          for (int e = 0; e < 4; ++e) GKL[kh * 1024 + (16 * m + 4 * fg + e) * 16 + fr] = acc[e]; }
        __syncthreads();
        if (tid < 256) {
            const int c = tid; float wr[16];
#pragma unroll
            for (int r = 0; r < 16; ++r) wr[r] = w2[r * 1024 + h * 256 + c];
            const float bb = b2[h * 256 + c]; float bc = 0.f;
#pragma unroll 2
            for (int t = 0; t < 64; ++t) { float z = bb;
#pragma unroll
                for (int r4 = 0; r4 < 4; ++r4) { const f32x4v a0 = *(const LAS f32x4v*)(GKL + t * 16 + 4 * r4), a1 = *(const LAS f32x4v*)(GKL + 1024 + t * 16 + 4 * r4);
                    z += (a0[0] + a1[0]) * wr[4 * r4] + (a0[1] + a1[1]) * wr[4 * r4 + 1] + (a0[2] + a1[2]) * wr[4 * r4 + 2] + (a0[3] + a1[3]) * wr[4 * r4 + 3]; }
                bc += -softplus_f(-z) * 0.0625f; BC[t * 256 + c] = bc; }
        } else {
#pragma unroll 1
            for (int cc = 0; cc < 2; ++cc) { const int col = (tid - 256) + 256 * cc; const bf16* vp = GV + (size_t)t0 * 2048 + h * 512 + col; v4u* dst = (v4u*)(ops + GL_VT + col * 128);
#pragma unroll 2
                for (int t8 = 0; t8 < 8; ++t8) { unsigned x[8];
#pragma unroll
                    for (int e = 0; e < 8; ++e) x[e] = vp[(size_t)(8 * t8 + e) * 2048];
                    v4u o4; o4.x = x[0] | (x[1] << 16); o4.y = x[2] | (x[3] << 16); o4.z = x[4] | (x[5] << 16); o4.w = x[6] | (x[7] << 16); dst[t8] = o4; } }
        }
        __syncthreads();
        { const int t = tid >> 3, cb = tid & 7, c0 = 32 * cb;
          const v4u* qg = (const v4u*)(GQ + (size_t)(t0 + t) * 1024 + h * 256 + c0); const v4u* kg = (const v4u*)(GK + (size_t)(t0 + t) * 1024 + h * 256 + c0);
          float qv[32], kv[32];
#pragma unroll
          for (int e = 0; e < 4; ++e) { const v4u a = qg[e], b = kg[e];
              qv[8 * e] = bflo(a.x); qv[8 * e + 1] = bfhi(a.x); qv[8 * e + 2] = bflo(a.y); qv[8 * e + 3] = bfhi(a.y); qv[8 * e + 4] = bflo(a.z); qv[8 * e + 5] = bfhi(a.z); qv[8 * e + 6] = bflo(a.w); qv[8 * e + 7] = bfhi(a.w);
              kv[8 * e] = bflo(b.x); kv[8 * e + 1] = bfhi(b.x); kv[8 * e + 2] = bflo(b.y); kv[8 * e + 3] = bfhi(b.y); kv[8 * e + 4] = bflo(b.z); kv[8 * e + 5] = bfhi(b.z); kv[8 * e + 6] = bflo(b.w); kv[8 * e + 7] = bfhi(b.w); }
#pragma unroll
          for (int e4 = 0; e4 < 8; ++e4) { const f32x4v b4 = *(const LAS f32x4v*)(BC + t * 256 + c0 + 4 * e4);
#pragma unroll
              for (int j = 0; j < 4; ++j) { const float eb = __expf(b4[j]), ib = __expf(-b4[j]); qv[4 * e4 + j] *= eb * 0.0625f; kv[4 * e4 + j] *= ib; } }
          LAS v4u* ql = (LAS v4u*)(lds + GLP_QPB + t * GLP_STR + 64 * cb); LAS v4u* kl = (LAS v4u*)(lds + GLP_KPB + t * GLP_STR + 64 * cb);
#pragma unroll
          for (int e = 0; e < 4; ++e) { v4u a, b; a.x = pk2(qv[8 * e], qv[8 * e + 1]); a.y = pk2(qv[8 * e + 2], qv[8 * e + 3]); a.z = pk2(qv[8 * e + 4], qv[8 * e + 5]); a.w = pk2(qv[8 * e + 6], qv[8 * e + 7]);
              b.x = pk2(kv[8 * e], kv[8 * e + 1]); b.y = pk2(kv[8 * e + 2], kv[8 * e + 3]); b.z = pk2(kv[8 * e + 4], kv[8 * e + 5]); b.w = pk2(kv[8 * e + 6], kv[8 * e + 7]); ql[e] = a; kl[e] = b; }
          v4u* qd = (v4u*)(ops + GL_QP + t * 512 + 64 * cb);
#pragma unroll
          for (int g = 0; g < 4; ++g) { v4u o4; o4.x = pk2(qv[4 * g], qv[4 * g + 1]); o4.y = pk2(qv[4 * g + 2], qv[4 * g + 3]); o4.z = pk2(qv[16 + 4 * g], qv[16 + 4 * g + 1]); o4.w = pk2(qv[16 + 4 * g + 2], qv[16 + 4 * g + 3]); qd[g] = o4; } }
        __syncthreads();
#pragma unroll 1
        for (int tt = 0; tt < 2; ++tt) { const int task = 2 * w + tt, mi = task >> 2, nj = task & 3; const int j = 16 * nj + fr;
            if (mi >= nj) { f32x4v acc = {0.f, 0.f, 0.f, 0.f};
                const LAS unsigned char* ab = lds + GLP_QPB + (16 * mi + fr) * GLP_STR + 16 * fg; const LAS unsigned char* bb = lds + GLP_KPB + (16 * nj + fr) * GLP_STR + 16 * fg;
#pragma unroll
                for (int s = 0; s < 8; ++s) acc = __builtin_amdgcn_mfma_f32_16x16x32_bf16(*(const LAS bf16x8*)(ab + 64 * s), *(const LAS bf16x8*)(bb + 64 * s), acc, 0, 0, 0);
#pragma unroll
                for (int e = 0; e < 4; ++e) { const int i = 16 * mi + 4 * fg + e; *(bf16*)(ops + GL_AI + (i * 64 + j) * 2) = (bf16)f2bf(i >= j ? acc[e] : 0.f); }
            } else {
#pragma unroll
                for (int e = 0; e < 4; ++e) { const int i = 16 * mi + 4 * fg + e; *(bf16*)(ops + GL_AI + (i * 64 + j) * 2) = (bf16)0; } } }
        { const int c = tid >> 1, tb = tid & 1; const float el = __expf(BC[63 * 256 + c]); float v[32];
#pragma unroll
          for (int e = 0; e < 32; ++e) v[e] = bf2f(*(const LAS bf16*)(lds + GLP_KPB + (32 * tb + e) * GLP_STR + 2 * c)) * el;
          v4u* dst = (v4u*)(ops + GL_KDT + c * 128 + 64 * tb);
#pragma unroll
          for (int e = 0; e < 4; ++e) { v4u o4; o4.x = pk2(v[8 * e], v[8 * e + 1]); o4.y = pk2(v[8 * e + 2], v[8 * e + 3]); o4.z = pk2(v[8 * e + 4], v[8 * e + 5]); o4.w = pk2(v[8 * e + 6], v[8 * e + 7]); dst[e] = o4; }
          if (tid < 256) ((float*)(ops + GL_DL))[tid] = __expf(BC[63 * 256 + tid]); }
        __syncthreads();
    }
}

constexpr int GS2_QP = 0, GS2_AI = 33792, GS2_KDT = 43008, GS2_DL = 79872;
template <int PASS> __device__ __forceinline__ void gla_scan_phase(Frame& F, const unsigned char* OPS, float* E, float* DGP, float* OG) {
    if (blockIdx.x >= 256) return;
    const int tid = opaque_tid(), lane = tid & 63, w = F.wave, fr = lane & 15, fg = lane >> 4;
    const int idx = blockIdx.x, g = idx & 15, cb = (idx >> 4) & 3, h = idx >> 6;
    LAS unsigned char* lds = F.lds;
    const int colh = 128 * cb + 16 * w + fr;
    f32x4v Sf[16];
#pragma unroll
    for (int t = 0; t < 16; ++t) Sf[t] = (f32x4v){0.f, 0.f, 0.f, 0.f};
    const unsigned gof = (unsigned)tid * 16u;
    const unsigned lQ = (unsigned)((tid >> 5) * 528 + (tid & 31) * 16), lB = (unsigned)((tid >> 3) * 144 + (tid & 7) * 16);
    v4u pq[4], pa, pk[4], pd; v4u pv[2];
#define GL_LOAD(n) do { const unsigned char* o_ = OPS + (size_t)(h * 128 + (n)) * GL_UNIT; \
        if (PASS == 2) { _Pragma("unroll") for (int e_ = 0; e_ < 4; ++e_) pq[e_] = *(const v4u*)(o_ + GL_QP + gof + 8192 * e_); pa = *(const v4u*)(o_ + GL_AI + gof); } \
        _Pragma("unroll") for (int e_ = 0; e_ < 4; ++e_) pk[e_] = *(const v4u*)(o_ + GL_KDT + gof + 8192 * e_); \
        if (tid < 64) pd = *(const v4u*)(o_ + GL_DL + gof); \
        _Pragma("unroll") for (int s_ = 0; s_ < 2; ++s_) pv[s_] = *(const v4u*)(o_ + GL_VT + (size_t)colh * 128 + 64 * s_ + 16 * fg); } while (0)
    GL_LOAD(GCH * g);
    if (PASS == 2) {
        for (int gp = 0; gp < g; ++gp) { const float* ep = E + ((((size_t)(h * NGRP + gp) * 4 + cb) * 8 + w) * 16) * 256 + lane * 4; const float* dp = DGP + (size_t)(h * NGRP + gp) * 256;
#pragma unroll
            for (int t = 0; t < 16; ++t) { const f32x4v d4 = *(const f32x4v*)(dp + 16 * t + 4 * fg), e4 = *(const f32x4v*)(ep + t * 256); Sf[t] = Sf[t] * d4 + e4; } }
    }
#define GL_STORE() do { \
        if (PASS == 2) { _Pragma("unroll") for (int e_ = 0; e_ < 4; ++e_) *(LAS v4u*)(lds + GS2_QP + lQ + 16 * 528 * e_) = pq[e_]; *(LAS v4u*)(lds + GS2_AI + lB) = pa; } \
        _Pragma("unroll") for (int e_ = 0; e_ < 4; ++e_) *(LAS v4u*)(lds + GS2_KDT + lB + 64 * 144 * e_) = pk[e_]; \
        if (tid < 64) *(LAS v4u*)(lds + GS2_DL + gof) = pd; } while (0)
    const unsigned aQ = (unsigned)(fr * 528 + fg * 16), aB = (unsigned)(fr * 144 + fg * 16);
    float dprod = 1.0f;
    for (int nn = 0; nn < GCH; ++nn) {
        const int n = GCH * g + nn;
        __syncthreads();
        GL_STORE();
        bf16x8 Vb[2]; Vb[0] = __builtin_bit_cast(bf16x8, pv[0]); Vb[1] = __builtin_bit_cast(bf16x8, pv[1]);
        __syncthreads();
        if (nn + 1 < GCH) GL_LOAD(n + 1);
        if (PASS == 1 && cb == 0 && tid < 256) dprod *= *(const LAS float*)(lds + GS2_DL + 4 * tid);
        if (PASS == 2) {
            bf16x8 Sb[8];
#pragma unroll
            for (int s = 0; s < 8; ++s) { v4u t; t.x = cvtpk(Sf[2 * s][0], Sf[2 * s][1]); t.y = cvtpk(Sf[2 * s][2], Sf[2 * s][3]); t.z = cvtpk(Sf[2 * s + 1][0], Sf[2 * s + 1][1]); t.w = cvtpk(Sf[2 * s + 1][2], Sf[2 * s + 1][3]); Sb[s] = __builtin_bit_cast(bf16x8, t); }
#pragma unroll
            for (int m = 0; m < 4; ++m) { f32x4v a = {0.f, 0.f, 0.f, 0.f};
#pragma unroll
                for (int s = 0; s < 8; ++s) a = __builtin_amdgcn_mfma_f32_16x16x32_bf16(*(const LAS bf16x8*)(lds + GS2_QP + aQ + m * 16 * 528 + s * 64), Sb[s], a, 0, 0, 0);
#pragma unroll
                for (int s = 0; s < 2; ++s) a = __builtin_amdgcn_mfma_f32_16x16x32_bf16(*(const LAS bf16x8*)(lds + GS2_AI + aB + m * 16 * 144 + s * 64), Vb[s], a, 0, 0, 0);
                float* op = OG + (size_t)(64 * n + 16 * m + 4 * fg) * 2048 + h * 512 + colh;
#pragma unroll
                for (int e = 0; e < 4; ++e) op[(size_t)e * 2048] = a[e]; }
        }
#pragma unroll
        for (int t = 0; t < 16; ++t) { const f32x4v d4 = *(const LAS f32x4v*)(lds + GS2_DL + (16 * t + 4 * fg) * 4); f32x4v a = Sf[t] * d4;
#pragma unroll
            for (int s = 0; s < 2; ++s) a = __builtin_amdgcn_mfma_f32_16x16x32_bf16(*(const LAS bf16x8*)(lds + GS2_KDT + aB + t * 16 * 144 + s * 64), Vb[s], a, 0, 0, 0);
            Sf[t] = a; }
    }
#undef GL_LOAD
#undef GL_STORE
    if (PASS == 1) {
        float* ep = E + ((((size_t)(h * NGRP + g) * 4 + cb) * 8 + w) * 16) * 256 + lane * 4;
#pragma unroll
        for (int t = 0; t < 16; ++t) *(f32x4v*)(ep + t * 256) = Sf[t];
        if (cb == 0 && tid < 256) DGP[(size_t)(h * NGRP + g) * 256 + tid] = dprod;
    }
    __syncthreads();
}
#ifndef PROBE_KIND
#define PROBE_KIND 0
#endif
#define REPS(kind) ((PROBE_KIND == (kind) || ((kind) == 9 && (PROBE_KIND == 13 || PROBE_KIND == 14))) ? 2 : 1)
#define RUN(kind, ...) do { for (int rep_ = 0; rep_ < REPS(kind); ++rep_) { __VA_ARGS__; if (rep_ + 1 < REPS(kind)) xcd_barrier(bar); } } while (0)
constexpr int PPL = 10, NPH = 2 + PPL * NLAYER;
__global__ void __launch_bounds__(NWAVES * 64, 2) fwd(Args a) {
    extern __shared__ __attribute__((aligned(16))) unsigned char lds[];
    Frame F;
    F.lds = (LAS unsigned char*)lds; F.ldsg = lds; F.MISC = (volatile LAS unsigned*)(F.lds + MISC_OFF);
    F.wave = __builtin_amdgcn_readfirstlane((int)threadIdx.x >> 6);
    F.G = gridDim.x; F.gw = blockIdx.x * NWAVES + F.wave; F.NGW = F.G * NWAVES;
    F.ws = a.ws; F.ctl = (gu32*)(a.ws + WS_CTL);
    for (int u = threadIdx.x; u < (LDS_BYTES - LDSCTL_OFF) / 4; u += NWAVES * 64) ((LAS unsigned*)(F.lds + LDSCTL_OFF))[u] = 0u;
    __syncthreads();
    const int lo = a.ph_lo, hi = a.ph_hi;
    XcdBarrier bar; bar.bar = (unsigned*)(F.ctl + CW_BAR); bar.x = 0; bar.st = nullptr;
    if (hi - lo > 1) bar = xcd_barrier_post((unsigned*)(F.ctl + CW_BAR), F.MISC + 8);
#define IN(k) (lo <= (k) && (k) < hi)
#define SEAM(k) do { if (IN(k) && IN((k) + 1)) xcd_barrier(bar); } while (0)
    unsigned char* ws = a.ws;
    bf16* H = (bf16*)(ws + WS_H); bf16* MIX = (bf16*)(ws + WS_MIX); bf16* HID = (bf16*)(ws + WS_HID);
    float* SSQ = (float*)(ws + WS_SSQ); float* BA = (float*)(ws + WS_BA); const float* cosT = (const float*)(ws + WS_COS); const float* sinT = (const float*)(ws + WS_SIN);
    float* OG = (float*)(ws + WS_OG); const float* MODS = (const float*)(ws + WS_MODS);
    float* X = a.out;
    const int vcu = (F.G % 8 == 0) ? ((int)blockIdx.x % 8) * (F.G / 8) + (int)blockIdx.x / 8 : (int)blockIdx.x;

    if (IN(0)) { RUN(1, p0_prologue(F, a)); } SEAM(0);

    for (int L = 0; L < NLAYER; ++L) {
        const int base = 1 + PPL * L, i = L >> 1; const bool odd = (L & 1) != 0;
        const float* xin0 = (L == 0) ? (const float*)a.in[0] : (const float*)X;
        bf16* CQ = (bf16*)(ws + WS_PROJ); bf16* CKV = CQ + (size_t)TOK * 512; bf16* QKV = CKV + (size_t)TOK * 512; bf16* Z = QKV + (size_t)TOK * 3072;
        bf16* GQ = (bf16*)(ws + WS_PROJ); bf16* GK = GQ + (size_t)TOK * 1024; bf16* GV = GK + (size_t)TOK * 1024; bf16* GR = GV + (size_t)TOK * 2048;
        bf16* QH = (bf16*)(ws + WS_QH); bf16* KH = (bf16*)(ws + WS_KH); bf16* VT = (bf16*)(ws + WS_VT);
        unsigned char* GDOPS = ws + WS_SCR + 100 * MiB; unsigned char* GLOPS = ws + WS_SCR; float* GLE = (float*)(ws + WS_SCR + 72 * MiB); float* GLD = (float*)(ws + WS_SCR + 104 * MiB);

        if (IN(base + 0)) RUN(2, norm_phase<0>(F, a, xin0, (const float*)a.in[3] + (size_t)(2 * L) * DM, 2 * L, H, nullptr));
        SEAM(base + 0);
        if (IN(base + 1)) {
            if (!odd) { pg8::Gemm g{H, (const bf16*)(ws + WS_WEIN) + (size_t)i * EIN_NP * DM, TOK, EIN_NP, DM}; pg8::StaticOrder S; S.init(TOK, EIN_NP, F.G, (int)blockIdx.x);
                pg8::EpiEvenIn E{CQ, CKV, QKV, Z, KH, SSQ, BA, cosT, sinT};
                RUN(3, pg8::gemm_phase<pg8::EpiEvenIn, pg8::StaticOrder, true, true>(F.lds, g, S, E));
            } else { pg8::Gemm g{H, (const bf16*)(ws + WS_WOIN) + (size_t)i * OIN_NP * DM, TOK, OIN_NP, DM}; pg8::StaticOrder S; S.init(TOK, OIN_NP, F.G, (int)blockIdx.x);
                pg8::EpiOddIn E{GQ, GK, GV, GR};
                RUN(4, pg8::gemm_phase<pg8::EpiOddIn, pg8::StaticOrder, true, true>(F.lds, g, S, E)); }
        }
        SEAM(base + 1);
        if (IN(base + 2)) {
            if (!odd) { RUN(5,
                { pg8::Gemm g{CQ, (const bf16*)(ws + WS_WUQ) + (size_t)i * 1536 * 512, TOK, 1536, 512}; pg8::StaticOrder S; S.init(TOK, 1536, F.G, (int)blockIdx.x);
                  pg8::EpiUq E{QH, SSQ, cosT, sinT, 0.10411754112770776f};
                  pg8::gemm_phase<pg8::EpiUq, pg8::StaticOrder, true, true>(F.lds, g, S, E); }
                { pg8::Gemm g{CKV, (const bf16*)(ws + WS_WUKV) + (size_t)i * 2048 * 512, TOK, 2048, 512}; pg8::StaticOrder S; S.init(TOK, 2048, F.G, (int)blockIdx.x);
                  pg8::EpiUkv E{KH, VT, SSQ};
                  pg8::gemm_phase<pg8::EpiUkv, pg8::StaticOrder, true, true>(F.lds, g, S, E); }
                gdn_prep_phase(F, QKV, BA, (const float*)a.in[11] + (size_t)i * 4 * 3072, (const float*)a.in[12] + i * 8, (const float*)a.in[13] + i * 8, GDOPS));
            } else RUN(6, gla_prep_phase(F, H, (const bf16*)(ws + WS_WGL) + (size_t)i * 16 * DM, (const float*)a.in[17] + (size_t)i * 16 * 1024, (const float*)a.in[18] + i * 1024, GQ, GK, GV, GLOPS));
        }
        SEAM(base + 2);
        float* GDQ = (float*)(ws + WS_SCR + 192 * MiB); bf16* GDP = (bf16*)(ws + WS_SCR + 200 * MiB);
        if (IN(base + 3)) {
            if (!odd) { RUN(7, if (blockIdx.x < 256) { const int hh_ = (int)blockIdx.x >> 5, gg_ = ((int)blockIdx.x >> 1) & 15;
                    if (blockIdx.x & 1) gdn_scan_phase<1>(F, GDOPS, GDQ, GDP, Z, nullptr, MIX, hh_, gg_); else gdn_scan_phase<0>(F, GDOPS, GDQ, GDP, Z, nullptr, MIX, hh_, gg_); });
            } else RUN(8, gla_scan_phase<1>(F, GLOPS, GLE, GLD, OG));
        }
        SEAM(base + 3);
        if (IN(base + 4)) {
            if (!odd) { RUN(9,
                if (vcu < 128 && (PROBE_KIND != 14 || rep_ == 0)) gdn_scan_phase<2>(F, GDOPS, GDQ, GDP, Z, (const float*)a.in[14] + i * 128, MIX, vcu >> 4, vcu & 15);
                if (PROBE_KIND != 13 || rep_ == 0) attn_phase(F, QH, KH, VT, MIX, (float*)(ws + WS_SCR), (float*)(ws + WS_SCR + AT_OPART_BYTES), vcu, 0));
            } else RUN(10, gla_scan_phase<2>(F, GLOPS, GLE, GLD, OG));
        }
        SEAM(base + 4);
        if (IN(base + 5)) { if (odd) RUN(11, gatenorm_phase<512>(F, OG, 2048, (const float*)a.in[19] + i * 512, GR, 2048, MIX, 0)); else attn_merge_phase(F, (const float*)(ws + WS_SCR), (const float*)(ws + WS_SCR + AT_OPART_BYTES), MIX, 0); }
        SEAM(base + 5);
        if (IN(base + 6)) {
            const bf16* Wt = odd ? (const bf16*)(ws + WS_WOOUT) + (size_t)i * DM * DM : (const bf16*)(ws + WS_WEOUT) + (size_t)i * DM * DM;
            pg8::Gemm g{MIX, Wt, TOK, DM, DM}; pg8::StaticOrder S; S.init(TOK, DM, F.G, (int)blockIdx.x);
            pg8::EpiResid E{xin0, X, MODS + (size_t)(2 * L) * 2048};
            pg8::gemm_phase<pg8::EpiResid, pg8::StaticOrder, true, true>(F.lds, g, S, E);
        }
        SEAM(base + 6);
        if (IN(base + 7)) norm_phase<0>(F, a, X, (const float*)a.in[3] + (size_t)(2 * L + 1) * DM, 2 * L + 1, H, nullptr);
        SEAM(base + 7);
        if (IN(base + 8)) {
            pg8::Gemm g{H, (const bf16*)(ws + WS_W13) + (size_t)L * 2 * DFF * DM, TOK, 2 * DFF, DM}; pg8::StaticOrder S; S.init(TOK, 2 * DFF, F.G, (int)blockIdx.x);
            pg8::EpiFfnUp E{HID};
            RUN(12, pg8::gemm_phase<pg8::EpiFfnUp, pg8::StaticOrder, true, true>(F.lds, g, S, E));
        }
        SEAM(base + 8);
        if (IN(base + 9)) {
            pg8::Gemm g{HID, (const bf16*)(ws + WS_W2) + (size_t)L * DM * DFF, TOK, DM, DFF}; pg8::StaticOrder S; S.init(TOK, DM, F.G, (int)blockIdx.x);
            pg8::EpiResid E{X, X, MODS + (size_t)(2 * L + 1) * 2048};
            pg8::gemm_phase<pg8::EpiResid, pg8::StaticOrder, true, true>(F.lds, g, S, E);
        }
        SEAM(base + 9);
    }
    if (IN(NPH - 1)) norm_phase<1>(F, a, X, (const float*)a.in[24], 0, nullptr, X);
#undef IN
#undef SEAM
}

extern "C" void kernel_launch(void* const* d_in, const int* in_sizes, int n_in, void* d_out, int out_size, void* d_ws, size_t ws_size, hipStream_t stream) {
    static int grid = 0;
    if (grid == 0) {
        if (n_in != 25 || out_size != TOK * DM || ws_size < WS_END) { fprintf(stderr, "kernel_launch: unexpected shapes (n_in %d, out %d, ws %zu < %zu)\n", n_in, out_size, ws_size, (size_t)WS_END); grid = -1; return; }
        int dev = 0, cus = 0;
        if (hipGetDevice(&dev) != hipSuccess || hipDeviceGetAttribute(&cus, hipDeviceAttributeMultiprocessorCount, dev) != hipSuccess) { grid = -1; return; }
        if (hipFuncSetAttribute((const void*)fwd, hipFuncAttributeMaxDynamicSharedMemorySize, LDS_BYTES) != hipSuccess) { fprintf(stderr, "kernel_launch: hipFuncSetAttribute failed\n"); grid = -1; return; }
        int per_cu = 0; (void)hipOccupancyMaxActiveBlocksPerMultiprocessor(&per_cu, (const void*)fwd, NWAVES * 64, LDS_BYTES); (void)hipGetLastError();
        if (per_cu < 1) fprintf(stderr, "kernel_launch: occupancy query reports %d blocks per CU\n", per_cu);
        grid = cus;
    }
    if (grid < 0) return;
    (void)hipMemsetAsync((char*)d_ws + WS_CTL, 0, CTL_ZERO_BYTES, stream);
    Args a{};
    for (int i = 0; i < 25; ++i) a.in[i] = d_in[i];
    a.out = (float*)d_out; a.ws = (unsigned char*)d_ws;
    auto run = [&](int lo, int hi) { a.ph_lo = lo; a.ph_hi = hi; hipLaunchKernelGGL(fwd, dim3(grid), dim3(NWAVES * 64), LDS_BYTES, stream, a); };
#if defined(MK_PER_PHASE)
    for (int p = 0; p < NPH; ++p) run(p, p + 1);
#else
    run(0, NPH);
#endif
}
```

```cpp
#include <hip/hip_runtime.h>
#include <cstdio>
#include <cstdint>

namespace pg8 {
#define PG8_LAS __attribute__((address_space(3)))
typedef unsigned short bf16_t;
typedef short bf16x8 __attribute__((ext_vector_type(8)));
typedef float f32x4 __attribute__((ext_vector_type(4)));
typedef unsigned u32x4 __attribute__((ext_vector_type(4)));
constexpr int BM = 256, BK = 64, HALF = 128, HTB = HALF * BK * 2  , STAGE_BYTES = 8 * HTB, NXCD = 8, WGM = 8;

__host__ __device__ __forceinline__ int lds_byte(int r, int c) { const int st = (r >> 4) * 2 + (c >> 5), rr = r & 15, cc = c & 31, ob = rr * 64 + cc * 2; return st * 1024 + (ob ^ (((ob >> 9) & 1) << 5)); }
__host__ __device__ __forceinline__ void stage_rc(int b, int& R, int& C) { const int st = b / 1024, sb = b % 1024, swz = sb ^ (((sb >> 9) & 1) << 5); R = (st >> 1) * 16 + swz / 64; C = (st & 1) * 32 + (swz % 64) / 2; }
__host__ __device__ __forceinline__ int perm32(int rho) { const int n = rho >> 4, i = rho & 15; return 8 * (i >> 2) + 4 * n + (i & 3); }

struct Unit { int pm, pn; };
struct Gemm { const bf16_t* A; const bf16_t* Bt; int M, N, K; };

struct StaticOrder {
    int nM, nN, nwg, G, c;
    __host__ __device__ void init(int M, int N, int G_, int c_) { nM = M / BM; nN = N / BM; nwg = nM * nN; G = G_; c = c_; }
    __host__ __device__ bool next(int i, Unit& u) const {
        const long L = (long)i * G + c; if (L >= nwg) return false;
        int wgid = (int)L; { const int q = nwg / NXCD, r = nwg % NXCD, xcd = wgid % NXCD, off = wgid / NXCD; wgid = (xcd < r ? xcd * (q + 1) : r * (q + 1) + (xcd - r) * q) + off; }
        const int nig = WGM * nN, gid = wgid / nig, fm = gid * WGM, gsz = (nM - fm) < WGM ? (nM - fm) : WGM;
        u.pm = fm + ((wgid % nig) % gsz); u.pn = (wgid % nig) / gsz; return true;
    }
    __device__ __forceinline__ void a_ready(const Unit&) const {}
    __device__ __forceinline__ void done(const Unit&) const {}
};

__device__ __forceinline__ unsigned cvt_pk_bf16(float lo, float hi) { unsigned r; asm volatile("v_cvt_pk_bf16_f32 %0, %1, %2" : "=v"(r) : "v"(lo), "v"(hi)); return r; }
typedef float f32x2 __attribute__((ext_vector_type(2)));
__device__ __forceinline__ u32x4 pack8(const f32x4& a, const f32x4& b) { u32x4 w; w.x = cvt_pk_bf16(a[0], a[1]); w.y = cvt_pk_bf16(a[2], a[3]); w.z = cvt_pk_bf16(b[0], b[1]); w.w = cvt_pk_bf16(b[2], b[3]); return w; }
__device__ __forceinline__ float sumsq4(const f32x4& a) { return (a[0] * a[0] + a[1] * a[1]) + (a[2] * a[2] + a[3] * a[3]); }
__device__ __forceinline__ void rope8(f32x4& v0, f32x4& v1, const f32x4& c4, const f32x4& s4) {
    const f32x4 a = v0, b = v1;
    v0[0] = a[0] * c4[0] - a[1] * s4[0]; v0[1] = a[1] * c4[0] + a[0] * s4[0];
    v0[2] = a[2] * c4[1] - a[3] * s4[1]; v0[3] = a[3] * c4[1] + a[2] * s4[1];
    v1[0] = b[0] * c4[2] - b[1] * s4[2]; v1[1] = b[1] * c4[2] + b[0] * s4[2];
    v1[2] = b[2] * c4[3] - b[3] * s4[3]; v1[3] = b[3] * c4[3] + b[2] * s4[3];
}
constexpr int TOK = 8192;
struct EpiEvenIn {
    static constexpr bool PERM = true, AFTER_DRAIN = false;
    bf16_t *CQ, *CKV, *QKV, *Z, *KH; float *SSQ, *BA; const float *cosT, *sinT;
    __device__ __forceinline__ void operator()(const f32x4 (&acc)[2][2][4][2], const Unit& u, int wr, int wc, int fr_in, int fq_in) const {
        int fr = fr_in, fq = fq_in; asm volatile("" : "+v"(fr), "+v"(fq));
        const int row0 = u.pm * BM + wr * 64 + fr;
        if (u.pn < 20) {
            bf16_t* base; int ldc, colt;
            if (u.pn < 2) { base = CQ; ldc = 512; colt = u.pn * 256; } else if (u.pn < 4) { base = CKV; ldc = 512; colt = (u.pn - 2) * 256; }
            else if (u.pn < 16) { base = QKV; ldc = 3072; colt = (u.pn - 4) * 256; } else { base = Z; ldc = 1024; colt = (u.pn - 16) * 256; }
            const int col0 = colt + wc * 32 + 8 * fq;
#pragma unroll
            for (int ai = 0; ai < 2; ++ai)
#pragma unroll
                for (int m = 0; m < 4; ++m) { const int row = row0 + ai * HALF + m * 16; bf16_t* rowp = base + (size_t)row * ldc + col0; float ss = 0.f;
#pragma unroll
                    for (int bj = 0; bj < 2; ++bj) { const f32x4 v0 = acc[ai][bj][m][0], v1 = acc[ai][bj][m][1]; ss += sumsq4(v0) + sumsq4(v1); *(u32x4*)(rowp + bj * HALF) = pack8(v0, v1); }
                    if (u.pn < 4) { const int ln = fq * 16 + fr; ss += __builtin_bit_cast(float, __builtin_amdgcn_ds_bpermute((ln ^ 16) << 2, __builtin_bit_cast(int, ss))); ss += __builtin_bit_cast(float, __builtin_amdgcn_ds_bpermute((ln ^ 32) << 2, __builtin_bit_cast(int, ss))); if (fq == 0) SSQ[(size_t)row * 16 + u.pn * 4 + wc] = ss; } }
        } else {
            if (wc < 2) {
#pragma unroll
                for (int ai = 0; ai < 2; ++ai)
#pragma unroll
                    for (int m = 0; m < 4; ++m) { const int row = row0 + ai * HALF + m * 16; f32x4 v0 = acc[ai][0][m][0], v1 = acc[ai][0][m][1];
                        const int i0 = 16 * wc + 4 * fq; const f32x4 c4 = *(const f32x4*)(cosT + (size_t)row * 32 + i0), s4 = *(const f32x4*)(sinT + (size_t)row * 32 + i0);
                        rope8(v0, v1, c4, s4); const u32x4 w = pack8(v0, v1);
#pragma unroll
                        for (int h = 0; h < 8; ++h) *(u32x4*)(KH + ((size_t)h * TOK + row) * 192 + 128 + 32 * wc + 8 * fq) = w; }
            } else if (wc == 2) {
                if (fq < 2) {
#pragma unroll
                    for (int ai = 0; ai < 2; ++ai)
#pragma unroll
                        for (int m = 0; m < 4; ++m) { const int row = row0 + ai * HALF + m * 16; float* p = BA + (size_t)row * 16 + 8 * fq; *(f32x4*)p = acc[ai][0][m][0]; *(f32x4*)(p + 4) = acc[ai][0][m][1]; }
                }
            }
        }
    }
};
struct EpiUq {
    static constexpr bool PERM = true, AFTER_DRAIN = false;
    bf16_t* QH; const float* SSQ; const float *cosT, *sinT; float qscale;
    __device__ __forceinline__ void operator()(const f32x4 (&acc)[2][2][4][2], const Unit& u, int wr, int wc, int fr_in, int fq_in) const {
        int fr = fr_in, fq = fq_in; asm volatile("" : "+v"(fr), "+v"(fq));
        const int row0 = u.pm * BM + wr * 64 + fr;
#pragma unroll
        for (int ai = 0; ai < 2; ++ai)
#pragma unroll
            for (int m = 0; m < 4; ++m) { const int row = row0 + ai * HALF + m * 16;
                const f32x4 p0 = *(const f32x4*)(SSQ + (size_t)row * 16), p1 = *(const f32x4*)(SSQ + (size_t)row * 16 + 4);
                const float ssum = ((p0[0] + p0[1]) + (p0[2] + p0[3])) + ((p1[0] + p1[1]) + (p1[2] + p1[3]));
                const float rq = rsqrtf(ssum * (1.0f / 512.0f) + 1e-6f) * qscale;
#pragma unroll
                for (int bj = 0; bj < 2; ++bj) { const int c8 = u.pn * BM + bj * HALF + wc * 32 + 8 * fq; const int head = c8 / 192, d = c8 - head * 192;
                    f32x4 v0 = acc[ai][bj][m][0] * rq, v1 = acc[ai][bj][m][1] * rq;
                    if (d >= 128) { const int i0 = (d - 128) >> 1; const f32x4 c4 = *(const f32x4*)(cosT + (size_t)row * 32 + i0), s4 = *(const f32x4*)(sinT + (size_t)row * 32 + i0); rope8(v0, v1, c4, s4); }
                    *(u32x4*)(QH + ((size_t)head * TOK + row) * 192 + d) = pack8(v0, v1); } }
    }
};
struct EpiUkv {
    static constexpr bool PERM = true, AFTER_DRAIN = false;
    bf16_t *KH, *VT; const float* SSQ;
    __device__ __forceinline__ void operator()(const f32x4 (&acc)[2][2][4][2], const Unit& u, int wr, int wc, int fr_in, int fq_in) const {
        int fr = fr_in, fq = fq_in; asm volatile("" : "+v"(fr), "+v"(fq));
        const int row0 = u.pm * BM + wr * 64 + fr, head = u.pn;
#pragma unroll
        for (int ai = 0; ai < 2; ++ai)
#pragma unroll
            for (int m = 0; m < 4; ++m) { const int row = row0 + ai * HALF + m * 16;
                const f32x4 p0 = *(const f32x4*)(SSQ + (size_t)row * 16 + 8), p1 = *(const f32x4*)(SSQ + (size_t)row * 16 + 12);
                const float ssum = ((p0[0] + p0[1]) + (p0[2] + p0[3])) + ((p1[0] + p1[1]) + (p1[2] + p1[3]));
                const float rk = rsqrtf(ssum * (1.0f / 512.0f) + 1e-6f);
                { const f32x4 v0 = acc[ai][0][m][0] * rk, v1 = acc[ai][0][m][1] * rk; *(u32x4*)(KH + ((size_t)head * TOK + row) * 192 + wc * 32 + 8 * fq) = pack8(v0, v1); }
                { const f32x4 v0 = acc[ai][1][m][0] * rk, v1 = acc[ai][1][m][1] * rk; const u32x4 w = pack8(v0, v1); bf16_t* vp = VT + ((size_t)head * 128 + wc * 32 + 8 * fq) * TOK + row;
                  vp[0 * TOK] = (bf16_t)(w.x & 0xffffu); vp[1 * TOK] = (bf16_t)(w.x >> 16); vp[2 * TOK] = (bf16_t)(w.y & 0xffffu); vp[3 * TOK] = (bf16_t)(w.y >> 16);
                  vp[4 * TOK] = (bf16_t)(w.z & 0xffffu); vp[5 * TOK] = (bf16_t)(w.z >> 16); vp[6 * TOK] = (bf16_t)(w.w & 0xffffu); vp[7 * TOK] = (bf16_t)(w.w >> 16); } }
    }
};
struct EpiOddIn {
    static constexpr bool PERM = true, AFTER_DRAIN = false;
    bf16_t *Q, *K, *V, *R;
    __device__ __forceinline__ void operator()(const f32x4 (&acc)[2][2][4][2], const Unit& u, int wr, int wc, int fr_in, int fq_in) const {
        int fr = fr_in, fq = fq_in; asm volatile("" : "+v"(fr), "+v"(fq));
        const int row0 = u.pm * BM + wr * 64 + fr;
        bf16_t* base; int ldc, colt;
        if (u.pn < 4) { base = Q; ldc = 1024; colt = u.pn * 256; } else if (u.pn < 8) { base = K; ldc = 1024; colt = (u.pn - 4) * 256; }
        else if (u.pn < 16) { base = V; ldc = 2048; colt = (u.pn - 8) * 256; } else { base = R; ldc = 2048; colt = (u.pn - 16) * 256; }
        const int col0 = colt + wc * 32 + 8 * fq;
#pragma unroll
        for (int ai = 0; ai < 2; ++ai)
#pragma unroll
            for (int m = 0; m < 4; ++m) { bf16_t* rowp = base + (size_t)(row0 + ai * HALF + m * 16) * ldc + col0;
#pragma unroll
                for (int bj = 0; bj < 2; ++bj) *(u32x4*)(rowp + bj * HALF) = pack8(acc[ai][bj][m][0], acc[ai][bj][m][1]); }
    }
};
struct EpiResid {
    static constexpr bool PERM = false, AFTER_DRAIN = false;
    const float* xin; float* xout; const float* gate;
    __device__ __forceinline__ void operator()(const f32x4 (&acc)[2][2][4][2], const Unit& u, int wr, int wc, int fr_in, int fq_in) const {
        int fr = fr_in, fq = fq_in; asm volatile("" : "+v"(fr), "+v"(fq));
        const int row0 = u.pm * BM + wr * 64 + fr, col0 = u.pn * BM + wc * 32 + 4 * fq;
        f32x4 gv[2][2];
#pragma unroll
        for (int bj = 0; bj < 2; ++bj)
#pragma unroll
            for (int n = 0; n < 2; ++n) gv[bj][n] = *(const f32x4*)(gate + col0 + bj * HALF + n * 16);
#pragma unroll
        for (int ai = 0; ai < 2; ++ai)
#pragma unroll
            for (int m = 0; m < 4; ++m) { const size_t off = (size_t)(row0 + ai * HALF + m * 16) * 2048 + col0;
#pragma unroll
                for (int bj = 0; bj < 2; ++bj)
#pragma unroll
                    for (int n = 0; n < 2; ++n) { const f32x4 x = *(const f32x4*)(xin + off + bj * HALF + n * 16); *(f32x4*)(xout + off + bj * HALF + n * 16) = x + gv[bj][n] * acc[ai][bj][m][n]; } }
    }
};
struct EpiFfnUp {
    static constexpr bool PERM = true, AFTER_DRAIN = false;
    bf16_t* HID;
    __device__ __forceinline__ void operator()(const f32x4 (&acc)[2][2][4][2], const Unit& u, int wr, int wc, int fr_in, int fq_in) const {
        int fr = fr_in, fq = fq_in; asm volatile("" : "+v"(fr), "+v"(fq));
        const int row0 = u.pm * BM + wr * 64 + fr, colh = u.pn * 128 + wc * 32 + 8 * fq;
#pragma unroll
        for (int ai = 0; ai < 2; ++ai)
#pragma unroll
            for (int m = 0; m < 4; ++m) { f32x4 h4[2];
#pragma unroll
                for (int bj = 0; bj < 2; ++bj) { const f32x4 a = acc[ai][bj][m][0], b = acc[ai][bj][m][1];
#pragma unroll
                    for (int j = 0; j < 4; ++j) h4[bj][j] = a[j] * __builtin_amdgcn_rcpf(1.0f + __builtin_amdgcn_exp2f(-1.4426950408889634f * a[j])) * b[j]; }
                *(u32x4*)(HID + (size_t)(row0 + ai * HALF + m * 16) * 5632 + colh) = pack8(h4[0], h4[1]); }
    }
};
template <class Epi, class Sched, bool ALIGN_EPI = false, bool SP2 = false>
__device__ __forceinline__ void gemm_phase(PG8_LAS unsigned char* lds, const Gemm g, const Sched& S, const Epi& E) {
    int tid_l = threadIdx.x; asm volatile("" : "+v"(tid_l));
    const int tid = tid_l, wid = __builtin_amdgcn_readfirstlane(tid >> 6), lane = tid & 63, wr = wid >> 2, wc = wid & 3, fr = lane & 15, fq = lane >> 4;
    const int K = g.K, nt = K / BK;
    unsigned voffA[2], voffB[2];
#pragma unroll
    for (int i = 0; i < 2; ++i) { int R, C; stage_rc(tid * 16 + i * 8192, R, C); const int Rb = Epi::PERM ? ((R & ~31) + perm32(R & 31)) : R;
        voffA[i] = (unsigned)(R * K + C) * 2u; voffB[i] = (unsigned)(Rb * K + C) * 2u; }
    const size_t kstep = (size_t)(BK * 2);
    const size_t hstep = (size_t)HALF * K * 2;
    const size_t tstep = 2 * hstep;
    const unsigned ldsw = (unsigned)wid * 1024u;
    const int aoff = lds_byte(wr * 64 + fr, fq * 8), boff = lds_byte(wc * 32 + fr, fq * 8);
#define PG8_SA(b, h) (((b) * 2 + (h)) * HTB)
#define PG8_SB(b, h) ((4 + (b) * 2 + (h)) * HTB)
#define PG8_STAGE(bufoff, gbase, voff) do { _Pragma("unroll") for (int _i = 0; _i < 2; ++_i) \
        __builtin_amdgcn_global_load_lds((const unsigned*)((const char*)(gbase) + (voff)[_i]), (PG8_LAS unsigned*)(lds + (bufoff) + ldsw + _i * 8192), 16, 0, 0); } while (0)
#define PG8_LDA(dst, b, h) do { _Pragma("unroll") for (int m = 0; m < 4; ++m) _Pragma("unroll") for (int k = 0; k < 2; ++k) dst[m][k] = *(const PG8_LAS bf16x8*)(lds + PG8_SA(b, h) + aoff + m * 2048 + k * 1024); } while (0)
#define PG8_LDB(dst, b, h) do { _Pragma("unroll") for (int n = 0; n < 2; ++n) _Pragma("unroll") for (int k = 0; k < 2; ++k) dst[n][k] = *(const PG8_LAS bf16x8*)(lds + PG8_SB(b, h) + boff + n * 2048 + k * 1024); } while (0)
#define PG8_MMA(ai, bj, At, Bt) do { __builtin_amdgcn_s_setprio(1); _Pragma("unroll") for (int m = 0; m < 4; ++m) _Pragma("unroll") for (int n = 0; n < 2; ++n) _Pragma("unroll") for (int k = 0; k < 2; ++k) \
        acc[ai][bj][m][n] = __builtin_amdgcn_mfma_f32_16x16x32_bf16(Bt[n][k], At[m][k], acc[ai][bj][m][n], 0, 0, 0); __builtin_amdgcn_s_setprio(0); } while (0)
#define PG8_WAIT_V(n) asm volatile("s_waitcnt vmcnt(" #n ")" ::: "memory")
#define PG8_WAIT_L(n) asm volatile("s_waitcnt lgkmcnt(" #n ")" ::: "memory")
#define PG8_BAR __builtin_amdgcn_s_barrier()
#define PG8_SCHED __builtin_amdgcn_sched_barrier(0)
    Unit cur, nxt; int ui = 0;
    if (!S.next(0, cur)) return;
    f32x4 acc[2][2][4][2];
#pragma unroll
    for (int a = 0; a < 2; ++a)
#pragma unroll
        for (int b = 0; b < 2; ++b)
#pragma unroll
            for (int m = 0; m < 4; ++m)
#pragma unroll
                for (int n = 0; n < 2; ++n) acc[a][b][m][n] = (f32x4){0.f, 0.f, 0.f, 0.f};
    bf16x8 At[4][2], B0[2][2], B1[2][2];
    const char* cA = (const char*)g.A + (size_t)cur.pm * tstep; const char* cB = (const char*)g.Bt + (size_t)cur.pn * tstep;
    S.a_ready(cur);
    if constexpr (SP2) {
        PG8_STAGE(PG8_SB(0, 0), cB, voffB); PG8_STAGE(PG8_SB(0, 1), cB + hstep, voffB); PG8_STAGE(PG8_SA(0, 0), cA, voffA); PG8_STAGE(PG8_SA(0, 1), cA + hstep, voffA);
        if (wr == 1) PG8_BAR;
        PG8_WAIT_V(2); PG8_BAR;
        PG8_STAGE(PG8_SB(1, 0), cB + kstep, voffB); PG8_STAGE(PG8_SA(1, 0), cA + kstep, voffA); PG8_STAGE(PG8_SB(1, 1), cB + hstep + kstep, voffB);
        PG8_WAIT_V(6); PG8_BAR;
    } else {
        PG8_STAGE(PG8_SB(0, 0), cB, voffB); PG8_STAGE(PG8_SA(0, 0), cA, voffA); PG8_STAGE(PG8_SB(0, 1), cB + hstep, voffB); PG8_STAGE(PG8_SA(0, 1), cA + hstep, voffA);
        if (wr == 1) PG8_BAR;
        PG8_WAIT_V(4); PG8_BAR;
        PG8_STAGE(PG8_SB(1, 0), cB + kstep, voffB); PG8_STAGE(PG8_SA(1, 0), cA + kstep, voffA); PG8_STAGE(PG8_SB(1, 1), cB + hstep + kstep, voffB);
        PG8_WAIT_V(6); PG8_BAR;
    }
    for (;;) {
        const bool has_next = S.next(ui + 1, nxt);
        const char* nA = has_next ? (const char*)g.A + (size_t)nxt.pm * tstep : cA; const char* nB = has_next ? (const char*)g.Bt + (size_t)nxt.pn * tstep : cB;
        for (int t = 0; t < nt; t += 2) {
            const bool last = (t == nt - 2);
            const char* a1 = cA + (size_t)(t + 1) * kstep;
            const char* a2 = last ? nA : cA + (size_t)(t + 2) * kstep; const char* b2 = last ? nB : cB + (size_t)(t + 2) * kstep;
            const char* a3 = a2 + kstep; const char* b3 = b2 + kstep;
            if (last && has_next) S.a_ready(nxt);
            if constexpr (SP2) {
            PG8_LDB(B0, 0, 0); PG8_LDB(B1, 0, 1); PG8_SCHED; PG8_LDA(At, 0, 0); PG8_STAGE(PG8_SA(1, 1), a1 + hstep, voffA);
            PG8_WAIT_V(8); PG8_WAIT_L(0); PG8_BAR; PG8_MMA(0, 0, At, B0); PG8_MMA(0, 1, At, B1); PG8_BAR; PG8_SCHED;
            PG8_LDA(At, 0, 1); PG8_STAGE(PG8_SB(0, 0), b2, voffB); PG8_STAGE(PG8_SB(0, 1), b2 + hstep, voffB); PG8_STAGE(PG8_SA(0, 0), a2, voffA);
            PG8_WAIT_V(8); PG8_WAIT_L(0); PG8_BAR; PG8_MMA(1, 0, At, B0); PG8_MMA(1, 1, At, B1); PG8_BAR; PG8_SCHED;
            PG8_LDB(B0, 1, 0); PG8_LDB(B1, 1, 1); PG8_SCHED; PG8_LDA(At, 1, 0); PG8_STAGE(PG8_SA(0, 1), a2 + hstep, voffA);
            PG8_WAIT_V(8); PG8_WAIT_L(0); PG8_BAR; PG8_MMA(0, 0, At, B0); PG8_MMA(0, 1, At, B1); PG8_BAR; PG8_SCHED;
            PG8_LDA(At, 1, 1); PG8_STAGE(PG8_SB(1, 0), b3, voffB); PG8_STAGE(PG8_SB(1, 1), b3 + hstep, voffB); PG8_STAGE(PG8_SA(1, 0), a3, voffA);
            PG8_WAIT_V(8); PG8_WAIT_L(0); PG8_BAR; PG8_MMA(1, 0, At, B0); PG8_MMA(1, 1, At, B1); PG8_BAR; PG8_SCHED;
            } else {
            PG8_LDB(B0, 0, 0); PG8_SCHED; PG8_LDA(At, 0, 0); PG8_STAGE(PG8_SA(1, 1), a1 + hstep, voffA);
            PG8_WAIT_L(8); PG8_BAR; PG8_WAIT_L(0); PG8_MMA(0, 0, At, B0); PG8_BAR; PG8_SCHED;
            PG8_LDB(B1, 0, 1); PG8_STAGE(PG8_SB(0, 0), b2, voffB);
            PG8_BAR; PG8_WAIT_L(0); PG8_MMA(0, 1, At, B1); PG8_BAR;
            PG8_LDA(At, 0, 1); PG8_STAGE(PG8_SA(0, 0), a2, voffA);
            PG8_BAR; PG8_WAIT_L(0); PG8_MMA(1, 0, At, B0); PG8_BAR; PG8_SCHED;
            PG8_STAGE(PG8_SB(0, 1), b2 + hstep, voffB);
            PG8_WAIT_V(6); PG8_BAR; PG8_MMA(1, 1, At, B1); PG8_BAR;
            PG8_LDB(B0, 1, 0); PG8_SCHED; PG8_LDA(At, 1, 0); PG8_STAGE(PG8_SA(0, 1), a2 + hstep, voffA);
            PG8_WAIT_L(8); PG8_BAR; PG8_WAIT_L(0); PG8_MMA(0, 0, At, B0); PG8_BAR; PG8_SCHED;
            PG8_LDB(B1, 1, 1); PG8_STAGE(PG8_SB(1, 0), b3, voffB);
            PG8_BAR; PG8_WAIT_L(0); PG8_MMA(0, 1, At, B1); PG8_BAR;
            PG8_LDA(At, 1, 1); PG8_STAGE(PG8_SA(1, 0), a3, voffA);
            PG8_BAR; PG8_WAIT_L(0); PG8_MMA(1, 0, At, B0); PG8_BAR; PG8_SCHED;
            PG8_STAGE(PG8_SB(1, 1), b3 + hstep, voffB);
            PG8_WAIT_V(6); PG8_BAR; PG8_MMA(1, 1, At, B1); PG8_BAR;
            }
        }
        if constexpr (ALIGN_EPI) { if (wr == 0) PG8_BAR; }
        if constexpr (!Epi::AFTER_DRAIN) { E(acc, cur, wr, wc, fr, fq); S.done(cur); }
        if (!has_next) break;
#pragma unroll
        for (int a = 0; a < 2; ++a)
#pragma unroll
            for (int b = 0; b < 2; ++b)
#pragma unroll
                for (int m = 0; m < 4; ++m)
#pragma unroll
                    for (int n = 0; n < 2; ++n) acc[a][b][m][n] = (f32x4){0.f, 0.f, 0.f, 0.f};
        cur = nxt; cA = nA; cB = nB; ++ui;
        if constexpr (ALIGN_EPI) { if (wr == 1) PG8_BAR; }
    }
    PG8_WAIT_V(0);
    if constexpr (!ALIGN_EPI) { if (wr == 0) PG8_BAR; }
    PG8_BAR;
    if constexpr (Epi::AFTER_DRAIN) { E.fused(acc, cur, wr, wc, fr, fq, lds, wid, lane); S.done(cur); }
#undef PG8_SA
#undef PG8_SB
#undef PG8_STAGE
#undef PG8_LDA
#undef PG8_LDB
#undef PG8_MMA
#undef PG8_WAIT_V
#undef PG8_WAIT_L
#undef PG8_BAR
#undef PG8_SCHED
}
}
#define GAS __attribute__((address_space(1)))
#define LAS __attribute__((address_space(3)))
typedef unsigned short bf16;
typedef unsigned v4u __attribute__((ext_vector_type(4)));
typedef unsigned v2u __attribute__((ext_vector_type(2)));
typedef float f32x4 __attribute__((ext_vector_type(4)));
typedef short bf16x8 __attribute__((ext_vector_type(8)));
typedef GAS unsigned gu32;
#define RLX_AGENT __ATOMIC_RELAXED, __HIP_MEMORY_SCOPE_AGENT
#define LDS_WAIT() asm volatile("s_waitcnt lgkmcnt(0)" ::: "memory")
#define VM_WAIT() asm volatile("s_waitcnt vmcnt(0)" ::: "memory")

constexpr int NWAVES = 8;
constexpr int TOK = 8192, DM = 2048, DFF = 5632, NLAYER = 4;
constexpr int EIN_SRC = 5200, EIN_NP = 5376, OIN_SRC = 6160, OIN_NP = 6144;
constexpr float EPS = 1e-6f;
constexpr size_t MiB = 1u << 20;
constexpr size_t WS_CTL = 0, CTL_ZERO_BYTES = 1 * MiB;
constexpr size_t WS_MODP = 1 * MiB;
constexpr size_t WS_MODS = 3 * MiB;
constexpr size_t WS_COS = 4 * MiB, WS_SIN = 5 * MiB;
constexpr size_t WS_SSQ = 6 * MiB;
constexpr size_t WS_BA = 6 * MiB + 512 * 1024;
constexpr size_t WS_WGL = 7 * MiB;
constexpr size_t WS_WEIN = 8 * MiB;
constexpr size_t WS_WUQ = WS_WEIN + 42 * MiB;
constexpr size_t WS_WUKV = WS_WUQ + 3 * MiB;
constexpr size_t WS_WEOUT = WS_WUKV + 4 * MiB;
constexpr size_t WS_WOIN = WS_WEOUT + 16 * MiB;
constexpr size_t WS_WOOUT = WS_WOIN + 48 * MiB;
constexpr size_t WS_W13 = WS_WOOUT + 16 * MiB;
constexpr size_t WS_W2 = WS_W13 + 176 * MiB;
constexpr size_t WS_H = WS_W2 + 88 * MiB;
constexpr size_t WS_PROJ = WS_H + 32 * MiB;
constexpr size_t WS_QH = WS_PROJ + 96 * MiB;
constexpr size_t WS_KH = WS_QH + 24 * MiB;
constexpr size_t WS_VT = WS_KH + 24 * MiB;
constexpr size_t WS_MIX = WS_VT + 16 * MiB;
constexpr size_t WS_HID = WS_MIX + 32 * MiB;
constexpr size_t WS_OG = WS_HID + 88 * MiB;
constexpr size_t WS_SCR = WS_OG + 64 * MiB;
constexpr size_t WS_END = WS_SCR + 256 * MiB;
constexpr int CW_BAR = 4096;
constexpr int RING_BYTES = 131072, LDSCTL_OFF = RING_BYTES, LDS_BYTES = 147456, MISC_OFF = LDS_BYTES - 256;

__device__ __forceinline__ unsigned f2bf(float f) { unsigned u = __builtin_bit_cast(unsigned, f); return (u + 0x7fffu + ((u >> 16) & 1u)) >> 16; }
__device__ __forceinline__ unsigned pk2(float lo, float hi) { return f2bf(lo) | (f2bf(hi) << 16); }
__device__ __forceinline__ float bf2f(unsigned b) { return __builtin_bit_cast(float, (b & 0xffffu) << 16); }
__device__ __forceinline__ float bflo(unsigned w) { return __builtin_bit_cast(float, w << 16); }
__device__ __forceinline__ float bfhi(unsigned w) { return __builtin_bit_cast(float, w & 0xffff0000u); }
__device__ __forceinline__ float shx(float v, int k, int lane) { return __builtin_bit_cast(float, __builtin_amdgcn_ds_bpermute((lane ^ k) << 2, __builtin_bit_cast(int, v))); }
__device__ __forceinline__ float wave_sum(float v, int lane) {
#pragma unroll
    for (int o = 1; o < 64; o <<= 1) v += shx(v, o, lane);
    return v;
}
__device__ __forceinline__ float wave_max(float v, int lane) {
#pragma unroll
    for (int o = 1; o < 64; o <<= 1) v = fmaxf(v, shx(v, o, lane));
    return v;
}
__device__ __forceinline__ float silu_f(float a) { return a / (1.0f + __expf(-a)); }
__device__ __forceinline__ float softplus_f(float x) { return x > 20.f ? x : log1pf(__expf(x)); }

__host__ __device__ __forceinline__ int map_ein(int c) { if (c < 1024) return c; if (c < 1088) { const int i = c - 1024; return 5120 + (i < 32 ? 2 * i : 2 * (i - 32) + 1); } if (c < 5184) return c - 64; return c; }
__host__ __device__ __forceinline__ int map_uq(int c) { const int h = c / 192, d = c - h * 192; if (d < 128) return c; const int i = d - 128; return h * 192 + 128 + (i < 32 ? 2 * i : 2 * (i - 32) + 1); }
__host__ __device__ __forceinline__ int map_w13(int hc, int n) { const int pn = hc >> 7, rem = hc & 127, wc = rem >> 5, fq = (rem >> 3) & 3, bj = (rem >> 2) & 1, j = rem & 3; return 256 * pn + 128 * bj + 32 * wc + 8 * fq + 4 * n + j; }
enum { K_PLAIN = 0, K_EIN = 1, K_UQ = 2, K_W1 = 3, K_W3 = 4, K_OIN = 5 };

struct Args { const void* in[25]; float* out; unsigned char* ws; int ph_lo, ph_hi; };
struct Frame {
    LAS unsigned char* lds; unsigned char* ldsg; volatile LAS unsigned* MISC; gu32* ctl; unsigned char* ws;
    int wave, G, gw, NGW;
};
__device__ __forceinline__ int opaque_tid() { int t = threadIdx.x; asm volatile("" : "+v"(t)); return t; }
struct WDesc { const float* W; int ld, ncols, K; const float* kscale; int kind; bf16* D0; bf16* D1; int nitems; };

__device__ __forceinline__ WDesc get_wdesc(const Args& a, int mi) {
    WDesc d; d.kscale = nullptr; d.D1 = nullptr; d.kind = K_PLAIN;
    unsigned char* ws = a.ws;
    if (mi < 8) { const int i = mi >> 2, w = mi & 3;
        if (w == 0) { d.W = (const float*)a.in[6] + (size_t)i * DM * EIN_SRC; d.ld = EIN_SRC; d.ncols = EIN_SRC; d.K = DM; d.kind = K_EIN; d.D0 = (bf16*)(ws + WS_WEIN) + (size_t)i * EIN_NP * DM; }
        else if (w == 1) { d.W = (const float*)a.in[8] + (size_t)i * 512 * 1536; d.ld = 1536; d.ncols = 1536; d.K = 512; d.kind = K_UQ; d.kscale = (const float*)a.in[7] + i * 512; d.D0 = (bf16*)(ws + WS_WUQ) + (size_t)i * 1536 * 512; }
        else if (w == 2) { d.W = (const float*)a.in[10] + (size_t)i * 512 * 2048; d.ld = 2048; d.ncols = 2048; d.K = 512; d.kscale = (const float*)a.in[9] + i * 512; d.D0 = (bf16*)(ws + WS_WUKV) + (size_t)i * 2048 * 512; }
        else { d.W = (const float*)a.in[15] + (size_t)i * DM * DM; d.ld = DM; d.ncols = DM; d.K = DM; d.D0 = (bf16*)(ws + WS_WEOUT) + (size_t)i * DM * DM; }
    } else if (mi < 12) { const int i = (mi - 8) >> 1, w = (mi - 8) & 1;
        if (w == 0) { d.W = (const float*)a.in[16] + (size_t)i * DM * OIN_SRC; d.ld = OIN_SRC; d.ncols = OIN_SRC; d.K = DM; d.kind = K_OIN; d.D0 = (bf16*)(ws + WS_WOIN) + (size_t)i * OIN_NP * DM; d.D1 = (bf16*)(ws + WS_WGL) + (size_t)i * 16 * DM; }
        else { d.W = (const float*)a.in[20] + (size_t)i * DM * DM; d.ld = DM; d.ncols = DM; d.K = DM; d.D0 = (bf16*)(ws + WS_WOOUT) + (size_t)i * DM * DM; }
    } else { const int l = (mi - 12) / 3, w = (mi - 12) - 3 * l;
        if (w == 0) { d.W = (const float*)a.in[21] + (size_t)l * DM * DFF; d.ld = DFF; d.ncols = DFF; d.K = DM; d.kind = K_W1; d.D0 = (bf16*)(ws + WS_W13) + (size_t)l * 2 * DFF * DM; }
        else if (w == 1) { d.W = (const float*)a.in[22] + (size_t)l * DM * DFF; d.ld = DFF; d.ncols = DFF; d.K = DM; d.kind = K_W3; d.D0 = (bf16*)(ws + WS_W13) + (size_t)l * 2 * DFF * DM; }
        else { d.W = (const float*)a.in[23] + (size_t)l * DFF * DM; d.ld = DM; d.ncols = DM; d.K = DFF; d.D0 = (bf16*)(ws + WS_W2) + (size_t)l * DM * DFF; }
    }
    d.nitems = ((d.ncols + 63) / 64) * (d.K / 64);
    return d;
}
__device__ __forceinline__ bf16* wrow_ptr(const WDesc& d, int col) {
    int r = col;
    if (d.kind == K_EIN) r = map_ein(col); else if (d.kind == K_UQ) r = map_uq(col); else if (d.kind == K_W1) r = map_w13(col, 0); else if (d.kind == K_W3) r = map_w13(col, 1);
    else if (d.kind == K_OIN) { if (col >= OIN_NP) return d.D1 + (size_t)(col - OIN_NP) * d.K; }
    return d.D0 + (size_t)r * d.K;
}
__device__ __forceinline__ void p0_item(const WDesc& d, LAS float* scr, int item, int lane) {
    const int ncb = (d.ncols + 63) / 64, kb = item / ncb, cb = item - kb * ncb, k0 = 64 * kb, c0 = 64 * cb;
    const int cc = c0 + lane; const bool cv = cc < d.ncols;
    const float* src = d.W + (size_t)k0 * d.ld + cc;
    float v[64];
#pragma unroll
    for (int i = 0; i < 64; ++i) v[i] = cv ? src[(size_t)i * d.ld] : 0.f;
    if (d.kscale) {
#pragma unroll
        for (int i = 0; i < 64; ++i) v[i] *= d.kscale[k0 + i]; }
#pragma unroll
    for (int i = 0; i < 64; ++i) scr[i * 65 + lane] = v[i];
    LDS_WAIT(); asm volatile("" ::: "memory");
    const int c = lane & 7;
#pragma unroll
    for (int j = 0; j < 8; ++j) { const int n = (lane >> 3) + 8 * j; const int col = c0 + n;
        if (col < d.ncols) { const LAS float* s = scr + (8 * c) * 65 + n;
            v4u o; o.x = pk2(s[0 * 65], s[1 * 65]); o.y = pk2(s[2 * 65], s[3 * 65]); o.z = pk2(s[4 * 65], s[5 * 65]); o.w = pk2(s[6 * 65], s[7 * 65]);
            *(GAS v4u*)(wrow_ptr(d, col) + k0 + 8 * c) = o; } }
    LDS_WAIT(); asm volatile("" ::: "memory");
}
constexpr int ADA_TASKS = 8 * 24 * 8;
__device__ __forceinline__ void p0_prologue(Frame& F, const Args& a) {
    LAS float* scr = (LAS float*)(F.lds + F.wave * 16640);
    const int tid = opaque_tid(), lane = tid & 63;
    if (F.gw < ADA_TASKS) { const int g = F.gw;
        const int m = g / 192, rem = g - m * 192, cg = rem >> 3, ks = rem & 7;
        const float* W = (const float*)a.in[4] + (size_t)m * DM * 6144 + (size_t)(ks * 256) * 6144 + cg * 256 + 4 * lane;
        const float* cvec = (const float*)a.in[1] + ks * 256;
        f32x4 acc = {0.f, 0.f, 0.f, 0.f};
#pragma unroll 8
        for (int k = 0; k < 256; ++k) { const float cv = cvec[k]; const float sc = cv / (1.0f + __expf(-cv)); const f32x4 w = *(const f32x4*)(W + (size_t)k * 6144); acc += w * sc; }
        *(f32x4*)((float*)(a.ws + WS_MODP) + ((size_t)(m * 8 + ks)) * 6144 + cg * 256 + 4 * lane) = acc;
    }
    { int T = 0;
      for (int mi = 0; mi < 24; ++mi) T += get_wdesc(a, mi).nitems;
      int g, gstep, glim;
      if (F.NGW > ADA_TASKS + 64) { const int cut = (ADA_TASKS * 22 < T) ? ADA_TASKS * 22 : T;
          if (F.gw < ADA_TASKS) { g = F.gw; gstep = ADA_TASKS; glim = cut; } else { g = cut + (F.gw - ADA_TASKS); gstep = F.NGW - ADA_TASKS; glim = T; } }
      else { g = F.gw; gstep = F.NGW; glim = T; }
      int mi = 0, mstart = 0; WDesc d = get_wdesc(a, 0);
      while (g < glim) { while (mi < 23 && g >= mstart + d.nitems) { mstart += d.nitems; ++mi; d = get_wdesc(a, mi); }
          p0_item(d, scr, g - mstart, lane); g += gstep; } }
    { const size_t per = (size_t)(EIN_NP - EIN_SRC) * DM / 8;
      for (size_t i = (size_t)blockIdx.x * 512 + tid; i < 2 * per; i += (size_t)F.G * 512) { const size_t l = i / per, r = i - l * per;
          *(v4u*)((bf16*)(a.ws + WS_WEIN) + l * EIN_NP * DM + (size_t)EIN_SRC * DM + r * 8) = (v4u){0u, 0u, 0u, 0u}; } }
    { const int* pos = (const int*)a.in[2]; float* ct = (float*)(a.ws + WS_COS); float* st = (float*)(a.ws + WS_SIN);
      for (int i = blockIdx.x * 512 + tid; i < TOK * 32; i += F.G * 512) { const int t = i >> 5, j = i & 31;
          const float inv = powf(10000.0f, -(float)j / 32.0f); const float ang = (float)pos[t] * inv; ct[i] = cosf(ang); st[i] = sinf(ang); } }
}
template <int MODE> __device__ __forceinline__ void norm_phase(Frame& F, const Args& a, const float* xin, const float* g, int modidx, bf16* H, float* outf) {
    float* gs = (float*)F.ldsg; float* sh = gs + 2048;
    const int tid_l = opaque_tid(), lane_l = tid_l & 63;
    for (int c = tid_l; c < 2048; c += 512) {
        const float gv = g[c];
        if (MODE == 0) { const float* bp = (const float*)a.in[5] + (size_t)modidx * 6144; const float* pp = (const float*)(a.ws + WS_MODP) + (size_t)modidx * 8 * 6144;
            float shf = bp[c], scl = bp[2048 + c], gt = bp[4096 + c];
#pragma unroll
            for (int ks = 0; ks < 8; ++ks) { shf += pp[ks * 6144 + c]; scl += pp[ks * 6144 + 2048 + c]; gt += pp[ks * 6144 + 4096 + c]; }
            gs[c] = gv * (1.0f + scl); sh[c] = shf;
            if (blockIdx.x == 0) ((float*)(a.ws + WS_MODS))[modidx * 2048 + c] = gt;
        } else { gs[c] = gv; sh[c] = 0.f; }
    }
    __syncthreads();
    int gw_l = F.gw; asm volatile("" : "+s"(gw_l));
    for (int m = gw_l; m < TOK; m += F.NGW) {
        const f32x4* xr = (const f32x4*)(xin + (size_t)m * DM) + lane_l;
        f32x4 v[8]; float s = 0.f;
#pragma unroll
        for (int j = 0; j < 8; ++j) { v[j] = xr[64 * j]; s += (v[j][0] * v[j][0] + v[j][1] * v[j][1]) + (v[j][2] * v[j][2] + v[j][3] * v[j][3]); }
        const float r = rsqrtf(wave_sum(s, lane_l) * (1.0f / DM) + EPS);
#pragma unroll
        for (int j = 0; j < 8; ++j) { const int col = 4 * lane_l + 256 * j; const f32x4 gg = *(const f32x4*)(gs + col), ss = *(const f32x4*)(sh + col);
            const f32x4 o = v[j] * r * gg + ss;
            if (MODE == 0) { v2u w; w.x = pk2(o[0], o[1]); w.y = pk2(o[2], o[3]); *(v2u*)(H + (size_t)m * DM + col) = w; }
            else *(f32x4*)(outf + (size_t)m * DM + col) = o; }
    }
    __syncthreads();
}
__device__ __forceinline__ void gatenorm_phase(Frame& F, const bf16* OG, const float* gnorm, const bf16* gatein, bf16* MIX) {
    const int lane_l = opaque_tid() & 63; int gw_l = F.gw; asm volatile("" : "+s"(gw_l));
    for (int m = gw_l; m < TOK; m += F.NGW) {
        const v4u* orow = (const v4u*)(OG + (size_t)m * DM + 32 * lane_l); float v[32]; float s = 0.f;
#pragma unroll
        for (int j = 0; j < 4; ++j) { const v4u t = orow[j]; v[8 * j] = bflo(t.x); v[8 * j + 1] = bfhi(t.x); v[8 * j + 2] = bflo(t.y); v[8 * j + 3] = bfhi(t.y); v[8 * j + 4] = bflo(t.z); v[8 * j + 5] = bfhi(t.z); v[8 * j + 6] = bflo(t.w); v[8 * j + 7] = bfhi(t.w); }
#pragma unroll
        for (int j = 0; j < 32; ++j) s += v[j] * v[j];
#pragma unroll
        for (int o = 1; o < 16; o <<= 1) s += shx(s, o, lane_l);
        const float r = rsqrtf(s * (1.0f / 512.0f) + EPS);
        const int cbase = 32 * lane_l, hc = cbase & 511;
        const bf16* zr = gatein + (size_t)m * DM + cbase; bf16* out = MIX + (size_t)m * DM + cbase;
#pragma unroll
        for (int j = 0; j < 32; j += 8) { const v4u zz = *(const v4u*)(zr + j); float z[8] = {bflo(zz.x), bfhi(zz.x), bflo(zz.y), bfhi(zz.y), bflo(zz.z), bfhi(zz.z), bflo(zz.w), bfhi(zz.w)}; float o8[8];
            const f32x4 g0 = *(const f32x4*)(gnorm + hc + j), g1 = *(const f32x4*)(gnorm + hc + j + 4); const float gg[8] = {g0[0], g0[1], g0[2], g0[3], g1[0], g1[1], g1[2], g1[3]};
#pragma unroll
            for (int e = 0; e < 8; ++e) o8[e] = v[j + e] * r * gg[e] * silu_f(z[e]);
            v4u w; w.x = pk2(o8[0], o8[1]); w.y = pk2(o8[2], o8[3]); w.z = pk2(o8[4], o8[5]); w.w = pk2(o8[6], o8[7]); *(v4u*)(out + j) = w; }
    }
}
#define XB_TMO      128
#define XB_XCNT(j)  (256  + 64 * (j))
#define XB_XSUB(j)  (1280 + 64 * (j))
#define XB_XGEN(j)  (2304 + 64 * (j))
#define XB_TOP      3328
#define XB_TOPGEN   3392
#define XCD_BAR_WORDS 3456
#define XB_SPIN_CAP (1u << 18)

__device__ __forceinline__ unsigned xb_ld(unsigned* p)              { return __hip_atomic_load(p, __ATOMIC_RELAXED, __HIP_MEMORY_SCOPE_AGENT); }
__device__ __forceinline__ unsigned xb_add(unsigned* p, unsigned v) { return __hip_atomic_fetch_add(p, v, __ATOMIC_RELAXED, __HIP_MEMORY_SCOPE_AGENT); }
__device__ __forceinline__ unsigned xb_xcc_id() { return (unsigned)__builtin_amdgcn_s_getreg((3 << 11) | 20) & 0xFu; }
#define XB_SPIN(cond, bar) do { unsigned _sp = 0; while (cond) { __builtin_amdgcn_s_sleep(1); \
    if ((++_sp & 255u) == 0u) { if (xb_ld(&(bar)[XB_TMO])) break; if (_sp > XB_SPIN_CAP) { atomicAdd(&(bar)[XB_TMO], 1u); break; } } } } while (0)

struct XcdBarrier {
    unsigned* bar; unsigned x;
    volatile LAS unsigned* st;
};

__device__ __forceinline__ XcdBarrier xcd_barrier_post(unsigned* bar, volatile LAS unsigned* st) {
    XcdBarrier b; b.bar = bar; b.x = xb_xcc_id(); b.st = st;
    if (threadIdx.x == 0) (void)xb_add(&bar[XB_XCNT(b.x)], 1u);
    return b;
}
__device__ __forceinline__ void xcd_barrier_complete(unsigned* bar, unsigned x, unsigned& nloc, unsigned& nx) {
    const unsigned G = gridDim.x * gridDim.y * gridDim.z;
    unsigned sum, cnt, mine, sp = 0u;
    for (;;) {
        sum = 0u; cnt = 0u; mine = 0u;
#pragma unroll
        for (unsigned j = 0; j < 16; ++j) { const unsigned c = xb_ld(&bar[XB_XCNT(j)]); sum += c; cnt += (c > 0u) ? 1u : 0u; mine = (j == x) ? c : mine; }
        if (sum == G) break;
        __builtin_amdgcn_s_sleep(1);
        if ((++sp & 255u) == 0u) { if (xb_ld(&bar[XB_TMO])) break; if (sp > XB_SPIN_CAP) { atomicAdd(&bar[XB_TMO], 1u); break; } }
    }
    nloc = mine > 0u ? mine : 1u; nx = cnt > 0u ? cnt : 1u;
}

__device__ __forceinline__ void xcd_barrier(const XcdBarrier& b) {
    asm volatile("s_waitcnt vmcnt(0)" ::: "memory");
    __syncthreads();
    if (threadIdx.x == 0) {
        unsigned* bar = b.bar;
        __builtin_amdgcn_s_waitcnt(0);
        unsigned nloc = b.st[0], nx = b.st[1];
        if (nloc == 0u) { xcd_barrier_complete(bar, b.x, nloc, nx); b.st[0] = nloc; b.st[1] = nx; }
        const unsigned old = xb_add(&bar[XB_XSUB(b.x)], 1u);
        const unsigned gen = old / nloc;
        if (old + 1u == (gen + 1u) * nloc) {
            __builtin_amdgcn_fence(__ATOMIC_RELEASE, "agent");
            asm volatile("s_waitcnt vmcnt(0)" ::: "memory");
            const unsigned og = xb_add(&bar[XB_TOP], 1u);
            const unsigned tg = og / nx;
            if (og + 1u == (tg + 1u) * nx) xb_add(&bar[XB_TOPGEN], 1u);
            else XB_SPIN(xb_ld(&bar[XB_TOPGEN]) == tg, bar);
            __builtin_amdgcn_fence(__ATOMIC_ACQUIRE, "agent");
            xb_add(&bar[XB_XGEN(b.x)], 1u);
            asm volatile("s_waitcnt vmcnt(0)" ::: "memory");
        } else {
            XB_SPIN(xb_ld(&bar[XB_XGEN(b.x)]) == gen, bar);
            __builtin_amdgcn_fence(__ATOMIC_ACQUIRE, "agent");
            asm volatile("s_waitcnt vmcnt(0)" ::: "memory");
        }
    }
    __syncthreads();
}
typedef float f32x16 __attribute__((ext_vector_type(16)));
constexpr int AT_TILES_HEAD = 2112, AT_TILES = 8 * AT_TILES_HEAD;
constexpr int AT_KSTR = 400, AT_VSTR = 136;
constexpr int AT_KBYTES = 64 * AT_KSTR, AT_VBYTES = 128 * AT_VSTR, AT_BUF = AT_KBYTES + AT_VBYTES;
constexpr size_t AT_OPART_BYTES = (size_t)256 * 3 * 256 * 128 * 4;
constexpr int AT_NSLOW = 128, AT_WA = 642, AT_WB = 9, AT_WF = 746;
__device__ __forceinline__ int at_start(int c, int nb) {
    long cw; if (c < AT_NSLOW) { const int q = c >> 4, r = c & 15; cw = (long)q * (16 * AT_WA - 120 * AT_WB) + (long)r * AT_WA - (long)AT_WB * (r * (r - 1) / 2); }
    else cw = 8L * (16 * AT_WA - 120 * AT_WB) + (long)AT_WF * (c - AT_NSLOW);
    const long W = 8L * (16 * AT_WA - 120 * AT_WB) + (long)AT_WF * (nb - AT_NSLOW); return (int)((cw * AT_TILES) / W); }
__device__ __forceinline__ void at_decode(int s, int& h, int& i, int& j) {
    h = s / AT_TILES_HEAD; const int r = s - h * AT_TILES_HEAD;
    int ii = (int)((sqrtf(1.0f + 2.0f * (float)r) - 1.0f) * 0.5f);
    if (ii < 0) ii = 0; if (ii > 31) ii = 31;
    while (ii < 31 && 2 * (ii + 1) * (ii + 2) <= r) ++ii;
    while (ii > 0 && 2 * ii * (ii + 1) > r) --ii;
    i = ii; j = r - 2 * ii * (ii + 1);
}
__device__ __forceinline__ int at_owner(int s, int nb) {
    int lo = 0, hi = nb - 1;
    while (lo < hi) { const int mid = (lo + hi + 1) >> 1; if (at_start(mid, nb) <= s) lo = mid; else hi = mid - 1; }
    return lo;
}
__device__ __forceinline__ float fexp2(float x) { return __builtin_amdgcn_exp2f(x); }
__device__ __forceinline__ unsigned cvtpk(float lo, float hi) { unsigned r; asm volatile("v_cvt_pk_bf16_f32 %0, %1, %2" : "=v"(r) : "v"(lo), "v"(hi)); return r; }

__device__ __forceinline__ void attn_phase(Frame& F, const bf16* QH, const bf16* KH, const bf16* VT, bf16* MIX, float* OPART, float* ML, int vcu, int b0) {
    const int nb = F.G - b0, c = vcu - b0;
    if (c < 0) return;
    const int tid = opaque_tid(), lane = tid & 63, w = F.wave, r = lane & 31, hh = lane >> 5;
    LAS unsigned char* lds = F.lds;
    const int kkey = tid >> 3, kc8 = tid & 7, vdv = tid >> 2, vc4 = tid & 3;
    const unsigned lK = (unsigned)(kkey * AT_KSTR + kc8 * 16), lV = (unsigned)(AT_KBYTES + vdv * AT_VSTR + vc4 * 16);
    const unsigned aK = (unsigned)(r * AT_KSTR + hh * 16), aV = (unsigned)(AT_KBYTES + r * AT_VSTR + hh * 8);
    int cur = at_start(c, nb); const int end = at_start(c + 1, nb);
    while (cur < end) {
        int h, i, j0; at_decode(cur, h, i, j0);
        const int n_i = 4 * (i + 1), j1 = (j0 + (end - cur) < n_i) ? j0 + (end - cur) : n_i, base = cur - j0;
        const bool whole = (j0 == 0) && (j1 == n_i);
        const int part = c - at_owner(base, nb);
        cur += j1 - j0;
        const int qrow = 256 * i + 32 * w + r;
        bf16x8 qf[12];
        { const bf16* qp = QH + ((size_t)h * TOK + qrow) * 192 + 8 * hh;
#pragma unroll
          for (int s = 0; s < 12; ++s) qf[s] = *(const bf16x8*)(qp + 16 * s); }
        f32x16 o[4];
#pragma unroll
        for (int d = 0; d < 4; ++d)
#pragma unroll
            for (int e = 0; e < 16; ++e) o[d][e] = 0.f;
        float m = -1e30f, l = 0.f;
        const bf16* gK = KH + ((size_t)h * TOK + kkey) * 192 + 8 * kc8;
        const bf16* gV = VT + ((size_t)h * 128 + vdv) * TOK + 8 * vc4;
        v4u kreg[3], vreg[2];
#define AT_LOAD(j) do { const bf16* pk_ = gK + (size_t)(j) * (64 * 192); const bf16* pv_ = gV + (size_t)(j) * 64; \
        kreg[0] = *(const v4u*)(pk_); kreg[1] = *(const v4u*)(pk_ + 64); kreg[2] = *(const v4u*)(pk_ + 128); vreg[0] = *(const v4u*)(pv_); vreg[1] = *(const v4u*)(pv_ + 32); } while (0)
#define AT_STORE(buf) do { LAS unsigned char* b_ = lds + (buf) * AT_BUF; \
        *(LAS v4u*)(b_ + lK) = kreg[0]; *(LAS v4u*)(b_ + lK + 128) = kreg[1]; *(LAS v4u*)(b_ + lK + 256) = kreg[2]; \
        *(LAS v2u*)(b_ + lV) = (v2u){vreg[0].x, vreg[0].y}; *(LAS v2u*)(b_ + lV + 8) = (v2u){vreg[0].z, vreg[0].w}; \
        *(LAS v2u*)(b_ + lV + 64) = (v2u){vreg[1].x, vreg[1].y}; *(LAS v2u*)(b_ + lV + 72) = (v2u){vreg[1].z, vreg[1].w}; } while (0)
        __syncthreads();
        AT_LOAD(j0); AT_STORE(0);
        __syncthreads();
        int cb = 0;
        for (int j = j0; j < j1; ++j) {
            if (j + 1 < j1) AT_LOAD(j + 1);
            const bool diag = (j >= 4 * i);
            if (!(diag && 64 * j > 256 * i + 32 * w + 31)) {
                LAS unsigned char* kb = lds + cb * AT_BUF;
                f32x16 s0, s1;
#pragma unroll
                for (int e = 0; e < 16; ++e) { s0[e] = 0.f; s1[e] = 0.f; }
#define AT_KF(kh, s) (*(const LAS bf16x8*)(kb + aK + (kh) * 32 * AT_KSTR + (s) * 32))
#define AT_KR(dst, s0_) do { _Pragma("unroll") for (int s_ = 0; s_ < 3; ++s_) { dst[2 * s_] = AT_KF(0, (s0_) + s_); dst[2 * s_ + 1] = AT_KF(1, (s0_) + s_); } } while (0)
#define AT_KM(src, s0_) do { _Pragma("unroll") for (int s_ = 0; s_ < 3; ++s_) { s0 = __builtin_amdgcn_mfma_f32_32x32x16_bf16(src[2 * s_], qf[(s0_) + s_], s0, 0, 0, 0); s1 = __builtin_amdgcn_mfma_f32_32x32x16_bf16(src[2 * s_ + 1], qf[(s0_) + s_], s1, 0, 0, 0); } } while (0)
                bf16x8 kfa[6];
                AT_KR(kfa, 0);
                __builtin_amdgcn_sched_barrier(0);
                AT_KM(kfa, 0); AT_KR(kfa, 3);
                __builtin_amdgcn_sched_barrier(0);
                AT_KM(kfa, 3); AT_KR(kfa, 6);
                __builtin_amdgcn_sched_barrier(0);
                AT_KM(kfa, 6); AT_KR(kfa, 9);
                __builtin_amdgcn_sched_barrier(0);
                AT_KM(kfa, 9);
                __builtin_amdgcn_sched_barrier(0);
#undef AT_KF
#undef AT_KR
#undef AT_KM
                if (diag) {
                    const int kq = 64 * j + 4 * hh - qrow;
#pragma unroll
                    for (int e = 0; e < 16; ++e) { const int ko = (e & 3) + 8 * (e >> 2);
                        if (kq + ko > 0) s0[e] = -INFINITY; if (kq + ko + 32 > 0) s1[e] = -INFINITY; }
                }
                float mx = fmaxf(s0[0], s1[0]);
#pragma unroll
                for (int e = 1; e < 16; ++e) mx = fmaxf(mx, fmaxf(s0[e], s1[e]));
                mx = fmaxf(mx, shx(mx, 32, lane));
                const float mn = fmaxf(m, mx), alpha = fexp2(m - mn); m = mn;
                float ps = 0.f;
#pragma unroll
                for (int e = 0; e < 16; ++e) { s0[e] = fexp2(s0[e] - mn); s1[e] = fexp2(s1[e] - mn); ps += s0[e] + s1[e]; }
                l = l * alpha + ps;
                if (__builtin_amdgcn_ballot_w64(alpha != 1.0f) != 0ull) {
#pragma unroll
                    for (int d = 0; d < 4; ++d)
#pragma unroll
                        for (int e = 0; e < 16; ++e) o[d][e] *= alpha; }
                bf16x8 pf[4];
                { v4u t;
                  t.x = cvtpk(s0[0], s0[1]); t.y = cvtpk(s0[2], s0[3]); t.z = cvtpk(s0[4], s0[5]); t.w = cvtpk(s0[6], s0[7]); pf[0] = __builtin_bit_cast(bf16x8, t);
                  t.x = cvtpk(s0[8], s0[9]); t.y = cvtpk(s0[10], s0[11]); t.z = cvtpk(s0[12], s0[13]); t.w = cvtpk(s0[14], s0[15]); pf[1] = __builtin_bit_cast(bf16x8, t);
                  t.x = cvtpk(s1[0], s1[1]); t.y = cvtpk(s1[2], s1[3]); t.z = cvtpk(s1[4], s1[5]); t.w = cvtpk(s1[6], s1[7]); pf[2] = __builtin_bit_cast(bf16x8, t);
                  t.x = cvtpk(s1[8], s1[9]); t.y = cvtpk(s1[10], s1[11]); t.z = cvtpk(s1[12], s1[13]); t.w = cvtpk(s1[14], s1[15]); pf[3] = __builtin_bit_cast(bf16x8, t); }
#define AT_VF(d, ks, dst) do { const v2u lo_ = *(const LAS v2u*)(kb + aV + (d) * 32 * AT_VSTR + (ks) * 32), hi_ = *(const LAS v2u*)(kb + aV + (d) * 32 * AT_VSTR + (ks) * 32 + 16); \
                    const v4u av_ = {lo_.x, lo_.y, hi_.x, hi_.y}; dst = __builtin_bit_cast(bf16x8, av_); } while (0)
                bf16x8 vfa[8];
#pragma unroll
                for (int e = 0; e < 8; ++e) AT_VF(e >> 2, e & 3, vfa[e]);
                __builtin_amdgcn_sched_barrier(0);
#pragma unroll
                for (int e = 0; e < 8; ++e) { const int d_ = e & 1, ks_ = e >> 1; o[d_] = __builtin_amdgcn_mfma_f32_32x32x16_bf16(vfa[4 * d_ + ks_], pf[ks_], o[d_], 0, 0, 0); }
                __builtin_amdgcn_sched_barrier(0);
#pragma unroll
                for (int e = 0; e < 8; ++e) AT_VF(2 + (e >> 2), e & 3, vfa[e]);
                __builtin_amdgcn_sched_barrier(0);
#pragma unroll
                for (int e = 0; e < 8; ++e) { const int d_ = e & 1, ks_ = e >> 1; o[2 + d_] = __builtin_amdgcn_mfma_f32_32x32x16_bf16(vfa[4 * d_ + ks_], pf[ks_], o[2 + d_], 0, 0, 0); }
                __builtin_amdgcn_sched_barrier(0);
#undef AT_VF
            }
            if (j + 1 < j1) AT_STORE(cb ^ 1);
            __syncthreads();
            cb ^= 1;
        }
#undef AT_LOAD
#undef AT_STORE
        const float lt = l + shx(l, 32, lane);
        if (whole) {
            const float inv = 1.0f / lt;
            bf16* op = MIX + (size_t)qrow * DM + h * 128 + 4 * hh;
#pragma unroll
            for (int d = 0; d < 4; ++d)
#pragma unroll
                for (int g4 = 0; g4 < 4; ++g4) { v2u wv; wv.x = pk2(o[d][4 * g4] * inv, o[d][4 * g4 + 1] * inv); wv.y = pk2(o[d][4 * g4 + 2] * inv, o[d][4 * g4 + 3] * inv);
                    *(v2u*)(op + 32 * d + 8 * g4) = wv; }
        } else {
            const size_t slot = (size_t)(h * 32 + i) * 3 + part;
            float* op = OPART + (slot * 256 + 32 * w + r) * 128 + 4 * hh;
#pragma unroll
            for (int d = 0; d < 4; ++d)
#pragma unroll
                for (int g4 = 0; g4 < 4; ++g4) *(f32x4*)(op + 32 * d + 8 * g4) = (f32x4){o[d][4 * g4], o[d][4 * g4 + 1], o[d][4 * g4 + 2], o[d][4 * g4 + 3]};
            if (hh == 0) { float* mp = ML + (slot * 256 + 32 * w + r) * 2; mp[0] = m; mp[1] = lt; }
        }
    }
    __syncthreads();
}
__device__ __forceinline__ void attn_merge_phase(Frame& F, const float* OPART, const float* ML, bf16* MIX, int b0) {
    const int nb = F.G - b0, lane = opaque_tid() & 63;
    int gw_l = F.gw; asm volatile("" : "+s"(gw_l));
    for (int task = gw_l; task < 256 * 256; task += F.NGW) {
        const int b = task >> 8, row = task & 255, h = b >> 5, i = b & 31;
        const int base = h * AT_TILES_HEAD + 2 * i * (i + 1), n_i = 4 * (i + 1);
        const int clo = at_owner(base, nb), chi = at_owner(base + n_i - 1, nb), np = chi - clo + 1;
        if (np <= 1) continue;
        float mk[3], lk[3]; float M = -1e30f;
#pragma unroll
        for (int k = 0; k < 3; ++k) { mk[k] = -1e30f; lk[k] = 0.f; if (k < np) { const float* mp = ML + (((size_t)b * 3 + k) * 256 + row) * 2; mk[k] = mp[0]; lk[k] = mp[1]; } M = fmaxf(M, mk[k]); }
        float L = 0.f, o0 = 0.f, o1 = 0.f;
#pragma unroll
        for (int k = 0; k < 3; ++k) if (k < np) { const float wk = fexp2(mk[k] - M); L += wk * lk[k]; const float* op = OPART + (((size_t)b * 3 + k) * 256 + row) * 128 + 2 * lane; o0 += wk * op[0]; o1 += wk * op[1]; }
        const float inv = 1.0f / L;
        *(unsigned*)(MIX + (size_t)(256 * i + row) * DM + h * 128 + 2 * lane) = pk2(o0 * inv, o1 * inv);
    }
}
constexpr int GD_WP = 0, GD_QD = 16384, GD_AI = 32768, GD_KDT = 40960, GD_U = 57344, GD_EGL = 90112, GD_UNIT = 90368;
constexpr size_t GD_OPS_BYTES = (size_t)1024 * GD_UNIT;
__host__ __device__ __forceinline__ int perm_pos(int o) { return (o < 16) ? 8 * (o >> 2) + (o & 3) : 8 * ((o - 16) >> 2) + 4 + (o & 3); }
constexpr int GP_XF = 0, GP_KF = 32768, GP_VF = 65536, GP_QB = 98304, GP_KB = 115712, GP_G = 133120;
constexpr int GP_BSTR = 272, GP_LSTR = 68;
typedef float f32x4v __attribute__((ext_vector_type(4)));

__device__ __forceinline__ void gdn_prep_phase(Frame& F, const bf16* QKV, const float* BA, const float* convw, const float* a_log, const float* dt_bias, unsigned char* OPS) {
    const int tid = opaque_tid(), lane = tid & 63, w = F.wave;
    LAS unsigned char* lds = F.lds;
    LAS float* XF = (LAS float*)(lds + GP_XF); LAS float* KF = (LAS float*)(lds + GP_KF); LAS float* VF = (LAS float*)(lds + GP_VF);
    LAS float* LM = (LAS float*)(lds + GP_XF);
    LAS float* gbeta = (LAS float*)(lds + GP_G); LAS float* ggc = gbeta + 64; LAS float* gegc = gbeta + 128;
    for (int unit = blockIdx.x; unit < 1024; unit += F.G) {
        const int h = unit & 7, n = unit >> 3, t0 = 64 * n;
        unsigned char* ops = OPS + (size_t)(h * 128 + n) * GD_UNIT;
        if (tid < 384) {
            const int seg = tid >> 7, rh = (tid >> 6) & 1, cp = tid & 63, ch = seg * 1024 + h * 128 + 2 * cp;
            float w0[4], w1[4];
#pragma unroll
            for (int j = 0; j < 4; ++j) { w0[j] = convw[j * 3072 + ch]; w1[j] = convw[j * 3072 + ch + 1]; }
            unsigned xv[35];
#pragma unroll
            for (int j = 0; j < 35; ++j) { const int tt = t0 + 32 * rh - 3 + j; xv[j] = (tt >= 0) ? *(const unsigned*)(QKV + (size_t)tt * 3072 + ch) : 0u; }
            LAS float* dst = (seg == 0 ? XF : seg == 1 ? KF : VF) + 2 * cp;
#pragma unroll
            for (int t = 0; t < 32; ++t) {
                const float y0 = w0[0] * bflo(xv[t]) + w0[1] * bflo(xv[t + 1]) + w0[2] * bflo(xv[t + 2]) + w0[3] * bflo(xv[t + 3]), y1 = w1[0] * bfhi(xv[t]) + w1[1] * bfhi(xv[t + 1]) + w1[2] * bfhi(xv[t + 2]) + w1[3] * bfhi(xv[t + 3]);
                dst[(32 * rh + t) * 128] = silu_f(y0); dst[(32 * rh + t) * 128 + 1] = silu_f(y1); }
        }
        __syncthreads();
        for (int rr = 0; rr < 16; ++rr) { const int row = w * 16 + rr;
            const bool isk = row >= 64; const int t = row & 63; LAS float* src = (isk ? KF : XF) + t * 128 + 2 * lane;
            const float v0 = src[0], v1 = src[1]; const float rn = rsqrtf(wave_sum(v0 * v0 + v1 * v1, lane) + EPS);
            if (isk) { src[0] = v0 * rn; src[1] = v1 * rn; *(LAS unsigned*)(lds + GP_KB + t * GP_BSTR + 4 * lane) = pk2(v0 * rn, v1 * rn); }
            else *(LAS unsigned*)(lds + GP_QB + t * GP_BSTR + 4 * lane) = pk2(v0 * rn * 0.08838834764831845f, v1 * rn * 0.08838834764831845f); }
        if (w == 0) {
            const float beta = 1.0f / (1.0f + __expf(-BA[(size_t)(t0 + lane) * 16 + h]));
            const float g = -__expf(a_log[h]) * softplus_f(BA[(size_t)(t0 + lane) * 16 + 8 + h] + dt_bias[h]);
            float gc = g;
#pragma unroll
            for (int d = 1; d < 64; d <<= 1) { const float up = __builtin_bit_cast(float, __builtin_amdgcn_ds_bpermute(((lane - d) & 63) << 2, __builtin_bit_cast(int, gc))); if (lane >= d) gc += up; }
            gbeta[lane] = beta; ggc[lane] = gc; gegc[lane] = __expf(gc); gbeta[192 + lane] = beta * __expf(gc);
        }
        __syncthreads();
        {   const int fr = lane & 15, fg = lane >> 4;
#pragma unroll 1
            for (int tt = 0; tt < 4; ++tt) { const int task = w * 4 + tt, isA = task >> 4, mi = (task >> 2) & 3, nj = task & 3;
                if (mi >= nj) {
                    f32x4v acc = {0.f, 0.f, 0.f, 0.f};
                    const LAS unsigned char* ab = lds + (isA ? GP_QB : GP_KB) + (16 * mi + fr) * GP_BSTR + 16 * fg; const LAS unsigned char* bb = lds + GP_KB + (16 * nj + fr) * GP_BSTR + 16 * fg;
#pragma unroll
                    for (int s = 0; s < 4; ++s) acc = __builtin_amdgcn_mfma_f32_16x16x32_bf16(*(const LAS bf16x8*)(ab + 64 * s), *(const LAS bf16x8*)(bb + 64 * s), acc, 0, 0, 0);
                    const int j = 16 * nj + fr; const float gj = ggc[j];
#pragma unroll
                    for (int e = 0; e < 4; ++e) { const int i = 16 * mi + 4 * fg + e; const float dec = __expf(ggc[i] - gj);
                        if (isA) { const float v = (i >= j) ? acc[e] * dec : 0.f; *(bf16*)(ops + GD_AI + i * 128 + ((j & 32) + perm_pos(j & 31)) * 2) = (bf16)f2bf(v); }
                        else { LM[i * GP_LSTR + j] = (i > j) ? acc[e] * dec * gbeta[i] : 0.f; } }
                } else if (isA) {
                    const int j = 16 * nj + fr;
#pragma unroll
                    for (int e = 0; e < 4; ++e) { const int i = 16 * mi + 4 * fg + e; *(bf16*)(ops + GD_AI + i * 128 + ((j & 32) + perm_pos(j & 31)) * 2) = (bf16)0; }
                }
            }
        }
        __syncthreads();
        if (tid < 256) {
            const int c = tid, isw = c >> 7, cc = c & 127;
            const LAS float* bsrc = (isw ? KF : VF) + cc; const LAS float* facp = gbeta + (isw ? 192 : 0);
            float x[64];
#pragma unroll
            for (int i = 0; i < 64; ++i) x[i] = 0.f;
#pragma unroll
            for (int i = 0; i < 64; ++i) {
                float acc = bsrc[i * 128] * facp[i], acc2 = 0.f;
#pragma unroll
                for (int j4 = 0; j4 < 16; ++j4) if (4 * j4 < i) { const f32x4v l4 = *(const LAS f32x4v*)(LM + i * GP_LSTR + 4 * j4);
                    acc -= l4[0] * x[4 * j4]; acc2 -= l4[1] * x[4 * j4 + 1]; acc -= l4[2] * x[4 * j4 + 2]; acc2 -= l4[3] * x[4 * j4 + 3]; }
                x[i] = acc + acc2;
                __builtin_amdgcn_sched_barrier(0);
            }
            if (isw) {
                bf16* wp = (bf16*)(ops + GD_WP) + (cc & 96) + perm_pos(cc & 31);
#pragma unroll
                for (int i = 0; i < 64; ++i) wp[i * 128] = (bf16)f2bf(x[i]);
            } else {
                float* up = (float*)(ops + GD_U) + (size_t)(cc >> 4) * 1024 + (cc & 15) * 4;
#pragma unroll
                for (int i = 0; i < 64; ++i) up[(i >> 4) * 256 + ((i & 15) >> 2) * 64 + (i & 3)] = x[i];
            }
        } else {
            const int u2 = tid - 256;
            { const int t = u2 >> 2, db = u2 & 3; const float eg = gegc[t]; const LAS unsigned* qs = (const LAS unsigned*)(lds + GP_QB + t * GP_BSTR + 64 * db);
              float v[32];
#pragma unroll
              for (int e = 0; e < 16; ++e) { const unsigned wv = qs[e]; v[2 * e] = bflo(wv) * eg; v[2 * e + 1] = bfhi(wv) * eg; }
              v4u o4[4];
#pragma unroll
              for (int g = 0; g < 4; ++g) { o4[g].x = pk2(v[4 * g], v[4 * g + 1]); o4[g].y = pk2(v[4 * g + 2], v[4 * g + 3]); o4[g].z = pk2(v[16 + 4 * g], v[16 + 4 * g + 1]); o4[g].w = pk2(v[16 + 4 * g + 2], v[16 + 4 * g + 3]); }
              v4u* dst = (v4u*)(ops + GD_QD + t * 256 + 64 * db);
#pragma unroll
              for (int g = 0; g < 4; ++g) dst[g] = o4[g]; }
            { const int d = u2 >> 1, tb = u2 & 1; const float gl = ggc[63];
              float v[32];
#pragma unroll
              for (int e = 0; e < 32; ++e) { const int t = 32 * tb + e; v[e] = KF[t * 128 + d] * __expf(gl - ggc[t]); }
              v4u* dst = (v4u*)(ops + GD_KDT + d * 128 + 64 * tb);
#pragma unroll
              for (int g = 0; g < 4; ++g) { v4u o4; o4.x = pk2(v[4 * g], v[4 * g + 1]); o4.y = pk2(v[4 * g + 2], v[4 * g + 3]); o4.z = pk2(v[16 + 4 * g], v[16 + 4 * g + 1]); o4.w = pk2(v[16 + 4 * g + 2], v[16 + 4 * g + 3]); dst[g] = o4; } }
            if (u2 == 0) *(float*)(ops + GD_EGL) = gegc[63];
        }
        __syncthreads();
    }
}

constexpr int GS_WP = 0, GS_QD = 17408, GS_AI = 34816, GS_KDT = 44032, GS_BUF = 62464, GS_OT = 2 * GS_BUF;
constexpr size_t GD_QG_BYTES = (size_t)8 * 16 * 128 * 128 * 4, GD_PG_BYTES = (size_t)8 * 16 * 128 * 128 * 2;
#define LDS_BAR() do { asm volatile("s_waitcnt lgkmcnt(0)" ::: "memory"); __builtin_amdgcn_s_barrier(); asm volatile("" ::: "memory"); } while (0)
template <int MODE> __device__ __forceinline__ void gdn_scan_phase(Frame& F, const unsigned char* OPS, float* QG, bf16* PG, const float* gnorm, bf16* MIX, int h, int g) {
    const int tid = opaque_tid(), lane = tid & 63, w = F.wave, fr = lane & 15, fg = lane >> 4;
    LAS unsigned char* lds = F.lds;
    const unsigned gofA = (unsigned)tid * 16u, lofA = (unsigned)((tid >> 4) * 272 + (tid & 15) * 16), lofB = (unsigned)((tid >> 3) * 144 + (tid & 7) * 16);
    const unsigned aA = (unsigned)(fr * 272 + fg * 16), aB = (unsigned)(fr * 144 + fg * 16);
    const int n0 = 8 * g;
    v4u pre[7]; f32x4v upre[4]; float eglp = 1.f;
#define GS_LOAD(n) do { const unsigned char* o_ = OPS + (size_t)(h * 128 + (n)) * GD_UNIT; \
        pre[0] = *(const v4u*)(o_ + GD_WP + gofA); pre[1] = *(const v4u*)(o_ + GD_WP + gofA + 8192); pre[5] = *(const v4u*)(o_ + GD_KDT + gofA); pre[6] = *(const v4u*)(o_ + GD_KDT + gofA + 8192); \
        if (MODE == 2) { pre[2] = *(const v4u*)(o_ + GD_QD + gofA); pre[3] = *(const v4u*)(o_ + GD_QD + gofA + 8192); pre[4] = *(const v4u*)(o_ + GD_AI + gofA); } \
        if (MODE != 1) { _Pragma("unroll") for (int m_ = 0; m_ < 4; ++m_) upre[m_] = *(const f32x4v*)(o_ + GD_U + ((size_t)(w * 4 + m_) * 64 + lane) * 16); } \
        eglp = *(const float*)(o_ + GD_EGL); } while (0)
#define GS_STORE(buf) do { LAS unsigned char* b_ = lds + (buf) * GS_BUF; \
        *(LAS v4u*)(b_ + GS_WP + lofA) = pre[0]; *(LAS v4u*)(b_ + GS_WP + lofA + 32 * 272) = pre[1]; *(LAS v4u*)(b_ + GS_KDT + lofB) = pre[5]; *(LAS v4u*)(b_ + GS_KDT + lofB + 64 * 144) = pre[6]; \
        if (MODE == 2) { *(LAS v4u*)(b_ + GS_QD + lofA) = pre[2]; *(LAS v4u*)(b_ + GS_QD + lofA + 32 * 272) = pre[3]; *(LAS v4u*)(b_ + GS_AI + lofB) = pre[4]; } } while (0)
    f32x4v Sf[8];
#pragma unroll
    for (int t = 0; t < 8; ++t)
#pragma unroll
        for (int e = 0; e < 4; ++e) Sf[t][e] = (MODE == 1 && (16 * t + 4 * fg + e) == (16 * w + fr)) ? 1.f : 0.f;
    GS_LOAD(n0);
    if (MODE == 2 && g > 0) {
        v4u pp[4]; f32x4v qpre[8], qcur[8];
#define GF_LOAD(gp) do { const unsigned char* p_ = (const unsigned char*)(PG + (size_t)(h * 16 + (gp)) * 16384); const float* q_ = QG + ((size_t)((h * 16 + (gp)) * 8 + w) * 8) * 256 + lane * 4; \
        _Pragma("unroll") for (int e_ = 0; e_ < 4; ++e_) pp[e_] = *(const v4u*)(p_ + gofA + 8192 * e_); _Pragma("unroll") for (int t_ = 0; t_ < 8; ++t_) qpre[t_] = *(const f32x4v*)(q_ + t_ * 256); } while (0)
#define GF_STORE(buf) do { LAS unsigned char* b_ = lds + (buf) * GS_BUF; _Pragma("unroll") for (int e_ = 0; e_ < 4; ++e_) *(LAS v4u*)(b_ + lofA + 32 * 272 * e_) = pp[e_]; } while (0)
        GF_LOAD(0); GF_STORE(0);
#pragma unroll
        for (int t = 0; t < 8; ++t) qcur[t] = qpre[t];
        LDS_BAR();
        for (int gp = 0; gp < g; ++gp) {
            if (gp + 1 < g) GF_LOAD(gp + 1);
            const LAS unsigned char* b = lds + (gp & 1) * GS_BUF;
            bf16x8 Sb[4];
#pragma unroll
            for (int s = 0; s < 4; ++s) { v4u t; t.x = cvtpk(Sf[2 * s][0], Sf[2 * s][1]); t.y = cvtpk(Sf[2 * s][2], Sf[2 * s][3]); t.z = cvtpk(Sf[2 * s + 1][0], Sf[2 * s + 1][1]); t.w = cvtpk(Sf[2 * s + 1][2], Sf[2 * s + 1][3]); Sb[s] = __builtin_bit_cast(bf16x8, t); }
#pragma unroll
            for (int t = 0; t < 8; ++t) { f32x4v a = qcur[t];
#pragma unroll
                for (int s = 0; s < 4; ++s) a = __builtin_amdgcn_mfma_f32_16x16x32_bf16(*(const LAS bf16x8*)(b + aA + t * 16 * 272 + s * 64), Sb[s], a, 0, 0, 0);
                Sf[t] = a; }
            if (gp + 1 < g) { GF_STORE((gp + 1) & 1);
#pragma unroll
                for (int t = 0; t < 8; ++t) qcur[t] = qpre[t]; }
            LDS_BAR();
        }
#undef GF_LOAD
#undef GF_STORE
    }
    GS_STORE(0);
    f32x4v ucur[4]; float egl = eglp;
#pragma unroll
    for (int m = 0; m < 4; ++m) ucur[m] = (MODE == 1) ? (f32x4v){0.f, 0.f, 0.f, 0.f} : upre[m];
    LDS_BAR();
    f32x4v gn4[4];
    if (MODE == 2) {
#pragma unroll
        for (int e = 0; e < 4; ++e) gn4[e] = *(const f32x4v*)(gnorm + 16 * (tid & 7) + 4 * e); }
    int cb = 0;
    for (int nn = 0; nn < 8; ++nn) {
        const int n = n0 + nn;
        if (nn + 1 < 8) GS_LOAD(n + 1);
        LAS unsigned char* b = lds + cb * GS_BUF;
        bf16x8 Sb[4];
#pragma unroll
        for (int s = 0; s < 4; ++s) { v4u t; t.x = cvtpk(Sf[2 * s][0], Sf[2 * s][1]); t.y = cvtpk(Sf[2 * s][2], Sf[2 * s][3]); t.z = cvtpk(Sf[2 * s + 1][0], Sf[2 * s + 1][1]); t.w = cvtpk(Sf[2 * s + 1][2], Sf[2 * s + 1][3]); Sb[s] = __builtin_bit_cast(bf16x8, t); }
        f32x4v vn[4], oo[4];
#pragma unroll
        for (int m = 0; m < 4; ++m) { f32x4v a1 = {0.f, 0.f, 0.f, 0.f}, a2 = {0.f, 0.f, 0.f, 0.f};
#pragma unroll
            for (int s = 0; s < 4; ++s) { a1 = __builtin_amdgcn_mfma_f32_16x16x32_bf16(*(const LAS bf16x8*)(b + GS_WP + aA + m * 16 * 272 + s * 64), Sb[s], a1, 0, 0, 0);
                if (MODE == 2) a2 = __builtin_amdgcn_mfma_f32_16x16x32_bf16(*(const LAS bf16x8*)(b + GS_QD + aA + m * 16 * 272 + s * 64), Sb[s], a2, 0, 0, 0); }
            vn[m] = ucur[m] - a1; oo[m] = a2; }
        bf16x8 Vb[2];
#pragma unroll
        for (int s = 0; s < 2; ++s) { v4u t; t.x = cvtpk(vn[2 * s][0], vn[2 * s][1]); t.y = cvtpk(vn[2 * s][2], vn[2 * s][3]); t.z = cvtpk(vn[2 * s + 1][0], vn[2 * s + 1][1]); t.w = cvtpk(vn[2 * s + 1][2], vn[2 * s + 1][3]); Vb[s] = __builtin_bit_cast(bf16x8, t); }
        if (MODE == 2) {
#pragma unroll
            for (int m = 0; m < 4; ++m)
#pragma unroll
                for (int s = 0; s < 2; ++s) oo[m] = __builtin_amdgcn_mfma_f32_16x16x32_bf16(*(const LAS bf16x8*)(b + GS_AI + aB + m * 16 * 144 + s * 64), Vb[s], oo[m], 0, 0, 0);
        }
#pragma unroll
        for (int t = 0; t < 8; ++t) { f32x4v a = Sf[t] * egl;
#pragma unroll
            for (int s = 0; s < 2; ++s) a = __builtin_amdgcn_mfma_f32_16x16x32_bf16(*(const LAS bf16x8*)(b + GS_KDT + aB + t * 16 * 144 + s * 64), Vb[s], a, 0, 0, 0);
            Sf[t] = a; }
        if (MODE == 2) {
#pragma unroll
            for (int m = 0; m < 4; ++m)
#pragma unroll
                for (int e = 0; e < 4; ++e) *(LAS bf16*)(lds + GS_OT + (16 * m + 4 * fg + e) * 272 + (16 * w + fr) * 2) = (bf16)f2bf(oo[m][e]);
        }
        if (nn + 1 < 8) GS_STORE(cb ^ 1);
        LDS_BAR();
        if (MODE == 2) {
            const int t = tid >> 3, sg = tid & 7;
            const v4u r0 = *(const LAS v4u*)(lds + GS_OT + t * 272 + sg * 32), r1 = *(const LAS v4u*)(lds + GS_OT + t * 272 + sg * 32 + 16);
            float v[16] = {bflo(r0.x), bfhi(r0.x), bflo(r0.y), bfhi(r0.y), bflo(r0.z), bfhi(r0.z), bflo(r0.w), bfhi(r0.w), bflo(r1.x), bfhi(r1.x), bflo(r1.y), bfhi(r1.y), bflo(r1.z), bfhi(r1.z), bflo(r1.w), bfhi(r1.w)};
            float q = 0.f;
#pragma unroll
            for (int e = 0; e < 16; ++e) q += v[e] * v[e];
            q += shx(q, 1, lane); q += shx(q, 2, lane); q += shx(q, 4, lane);
            const float rn = rsqrtf(q * (1.0f / 128.0f) + EPS);
            v4u o0, o1;
            o0.x = pk2(v[0] * rn * gn4[0][0], v[1] * rn * gn4[0][1]); o0.y = pk2(v[2] * rn * gn4[0][2], v[3] * rn * gn4[0][3]); o0.z = pk2(v[4] * rn * gn4[1][0], v[5] * rn * gn4[1][1]); o0.w = pk2(v[6] * rn * gn4[1][2], v[7] * rn * gn4[1][3]);
            o1.x = pk2(v[8] * rn * gn4[2][0], v[9] * rn * gn4[2][1]); o1.y = pk2(v[10] * rn * gn4[2][2], v[11] * rn * gn4[2][3]); o1.z = pk2(v[12] * rn * gn4[3][0], v[13] * rn * gn4[3][1]); o1.w = pk2(v[14] * rn * gn4[3][2], v[15] * rn * gn4[3][3]);
            bf16* op = MIX + (size_t)(64 * n + t) * DM + 1024 + h * 128 + 16 * sg;
            *(v4u*)op = o0; *(v4u*)(op + 8) = o1;
            LDS_BAR();
        }
        if (nn + 1 < 8) {
#pragma unroll
            for (int m = 0; m < 4; ++m) ucur[m] = (MODE == 1) ? (f32x4v){0.f, 0.f, 0.f, 0.f} : upre[m];
            egl = eglp; }
        cb ^= 1;
    }
#undef GS_LOAD
#undef GS_STORE
    if (MODE == 0) { float* qp = QG + ((size_t)((h * 16 + g) * 8 + w) * 8) * 256 + lane * 4;
#pragma unroll
        for (int t = 0; t < 8; ++t) *(f32x4v*)(qp + t * 256) = Sf[t]; }
    if (MODE == 1) { const int col = 16 * w + fr; bf16* pp = PG + ((size_t)(h * 16 + g) * 128) * 128 + (col & 96) + perm_pos(col & 31);
#pragma unroll
        for (int t = 0; t < 8; ++t)
#pragma unroll
            for (int e = 0; e < 4; ++e) pp[(size_t)(16 * t + 4 * fg + e) * 128] = (bf16)f2bf(Sf[t][e]); }
    __syncthreads();
}
__device__ __forceinline__ void gdn_gate_phase(Frame& F, const bf16* Z, bf16* MIX) {
    const int lane = opaque_tid() & 63; int gw_l = F.gw; asm volatile("" : "+s"(gw_l));
    for (int m = gw_l; m < TOK; m += F.NGW) {
        bf16* op = MIX + (size_t)m * DM + 1024 + 16 * lane; const bf16* zp = Z + (size_t)m * 1024 + 16 * lane;
#pragma unroll
        for (int j = 0; j < 2; ++j) { const v4u a = *(const v4u*)(op + 8 * j), z = *(const v4u*)(zp + 8 * j); v4u o;
            o.x = pk2(bflo(a.x) * silu_f(bflo(z.x)), bfhi(a.x) * silu_f(bfhi(z.x))); o.y = pk2(bflo(a.y) * silu_f(bflo(z.y)), bfhi(a.y) * silu_f(bfhi(z.y)));
            o.z = pk2(bflo(a.z) * silu_f(bflo(z.z)), bfhi(a.z) * silu_f(bfhi(z.z))); o.w = pk2(bflo(a.w) * silu_f(bflo(z.w)), bfhi(a.w) * silu_f(bfhi(z.w)));
            *(v4u*)(op + 8 * j) = o; }
    }
}
constexpr int GL_QP = 0, GL_AI = 32768, GL_KDT = 40960, GL_VT = 73728, GL_DL = 139264, GL_UNIT = 140288;
constexpr size_t GL_OPS_BYTES = (size_t)512 * GL_UNIT;
constexpr int GLP_GKL = 0, GLP_BC = 8192, GLP_QPB = 73728, GLP_KPB = 107520, GLP_STR = 528;
constexpr int NGRP = 16, GCH = 8;

__device__ __forceinline__ void gla_prep_phase(Frame& F, const bf16* H, const bf16* WGL, const float* w2, const float* b2, const bf16* GQ, const bf16* GK, const bf16* GV, unsigned char* OPS) {
    const int tid = opaque_tid(), lane = tid & 63, w = F.wave, fr = lane & 15, fg = lane >> 4;
    LAS unsigned char* lds = F.lds;
    LAS float* GKL = (LAS float*)(lds + GLP_GKL); LAS float* BC = (LAS float*)(lds + GLP_BC);
    for (int unit = blockIdx.x; unit < 512; unit += F.G) {
        const int h = unit & 3, n = unit >> 2, t0 = 64 * n;
        unsigned char* ops = OPS + (size_t)(h * 128 + n) * GL_UNIT;
        { const int m = w & 3, kh = w >> 2; f32x4v acc = {0.f, 0.f, 0.f, 0.f};
          const bf16* ap = H + (size_t)(t0 + 16 * m + fr) * DM + 1024 * kh + 8 * fg; const bf16* bp = WGL + (size_t)fr * DM + 1024 * kh + 8 * fg;
#pragma unroll 8
          for (int s = 0; s < 32; ++s) acc = __builtin_amdgcn_mfma_f32_16x16x32_bf16(*(const bf16x8*)(ap + 32 * s), *(const bf16x8*)(bp + 32 * s), acc, 0, 0, 0);
#pragma unroll
          for (int e = 0; e < 4; ++e) GKL[kh * 1024 + (16 * m + 4 * fg + e) * 16 + fr] = acc[e]; }
        __syncthreads();
        { const int c = tid & 255, th = tid >> 8; float wr[16];
#pragma unroll
          for (int r = 0; r < 16; ++r) wr[r] = w2[r * 1024 + h * 256 + c];
          const float bb = b2[h * 256 + c];
#pragma unroll 4
          for (int tt = 0; tt < 32; ++tt) { const int t = 32 * th + tt; float z = bb;
#pragma unroll
              for (int r4 = 0; r4 < 4; ++r4) { const f32x4v a0 = *(const LAS f32x4v*)(GKL + t * 16 + 4 * r4), a1 = *(const LAS f32x4v*)(GKL + 1024 + t * 16 + 4 * r4);
                  z += (a0[0] + a1[0]) * wr[4 * r4] + (a0[1] + a1[1]) * wr[4 * r4 + 1] + (a0[2] + a1[2]) * wr[4 * r4 + 2] + (a0[3] + a1[3]) * wr[4 * r4 + 3]; }
              BC[t * 256 + c] = -softplus_f(-z) * 0.0625f; } }
        __syncthreads();
        if (tid < 256) { float bc = 0.f;
#pragma unroll 8
            for (int t = 0; t < 64; ++t) { bc += BC[t * 256 + tid]; BC[t * 256 + tid] = bc; }
        } else {
#pragma unroll 1
            for (int cc = 0; cc < 2; ++cc) { const int col = (tid - 256) + 256 * cc; const bf16* vp = GV + (size_t)t0 * 2048 + h * 512 + col; v4u* dst = (v4u*)(ops + GL_VT + col * 128);
#pragma unroll
                for (int t8 = 0; t8 < 8; ++t8) { unsigned x[8];
#pragma unroll
                    for (int e = 0; e < 8; ++e) x[e] = vp[(size_t)(8 * t8 + e) * 2048];
                    v4u o4; o4.x = x[0] | (x[1] << 16); o4.y = x[2] | (x[3] << 16); o4.z = x[4] | (x[5] << 16); o4.w = x[6] | (x[7] << 16); dst[t8] = o4; } }
        }
        __syncthreads();
        { const int t = tid >> 3, cb = tid & 7, c0 = 32 * cb;
          const v4u* qg = (const v4u*)(GQ + (size_t)(t0 + t) * 1024 + h * 256 + c0); const v4u* kg = (const v4u*)(GK + (size_t)(t0 + t) * 1024 + h * 256 + c0);
          float qv[32], kv[32];
#pragma unroll
          for (int e = 0; e < 4; ++e) { const v4u a = qg[e], b = kg[e];
              qv[8 * e] = bflo(a.x); qv[8 * e + 1] = bfhi(a.x); qv[8 * e + 2] = bflo(a.y); qv[8 * e + 3] = bfhi(a.y); qv[8 * e + 4] = bflo(a.z); qv[8 * e + 5] = bfhi(a.z); qv[8 * e + 6] = bflo(a.w); qv[8 * e + 7] = bfhi(a.w);
              kv[8 * e] = bflo(b.x); kv[8 * e + 1] = bfhi(b.x); kv[8 * e + 2] = bflo(b.y); kv[8 * e + 3] = bfhi(b.y); kv[8 * e + 4] = bflo(b.z); kv[8 * e + 5] = bfhi(b.z); kv[8 * e + 6] = bflo(b.w); kv[8 * e + 7] = bfhi(b.w); }
#pragma unroll
          for (int e4 = 0; e4 < 8; ++e4) { const f32x4v b4 = *(const LAS f32x4v*)(BC + t * 256 + c0 + 4 * e4);
#pragma unroll
              for (int j = 0; j < 4; ++j) { const float eb = __expf(b4[j]), ib = __expf(-b4[j]); qv[4 * e4 + j] *= eb * 0.0625f; kv[4 * e4 + j] *= ib; } }
          LAS v4u* ql = (LAS v4u*)(lds + GLP_QPB + t * GLP_STR + 64 * cb); LAS v4u* kl = (LAS v4u*)(lds + GLP_KPB + t * GLP_STR + 64 * cb);
#pragma unroll
          for (int e = 0; e < 4; ++e) { v4u a, b; a.x = pk2(qv[8 * e], qv[8 * e + 1]); a.y = pk2(qv[8 * e + 2], qv[8 * e + 3]); a.z = pk2(qv[8 * e + 4], qv[8 * e + 5]); a.w = pk2(qv[8 * e + 6], qv[8 * e + 7]);
              b.x = pk2(kv[8 * e], kv[8 * e + 1]); b.y = pk2(kv[8 * e + 2], kv[8 * e + 3]); b.z = pk2(kv[8 * e + 4], kv[8 * e + 5]); b.w = pk2(kv[8 * e + 6], kv[8 * e + 7]); ql[e] = a; kl[e] = b; }
          v4u* qd = (v4u*)(ops + GL_QP + t * 512 + 64 * cb);
#pragma unroll
          for (int g = 0; g < 4; ++g) { v4u o4; o4.x = pk2(qv[4 * g], qv[4 * g + 1]); o4.y = pk2(qv[4 * g + 2], qv[4 * g + 3]); o4.z = pk2(qv[16 + 4 * g], qv[16 + 4 * g + 1]); o4.w = pk2(qv[16 + 4 * g + 2], qv[16 + 4 * g + 3]); qd[g] = o4; } }
        __syncthreads();
#pragma unroll 1
        for (int tt = 0; tt < 2; ++tt) { const int task = 2 * w + tt, mi = task >> 2, nj = task & 3; const int j = 16 * nj + fr;
            if (mi >= nj) { f32x4v acc = {0.f, 0.f, 0.f, 0.f};
                const LAS unsigned char* ab = lds + GLP_QPB + (16 * mi + fr) * GLP_STR + 16 * fg; const LAS unsigned char* bb = lds + GLP_KPB + (16 * nj + fr) * GLP_STR + 16 * fg;
#pragma unroll
                for (int s = 0; s < 8; ++s) acc = __builtin_amdgcn_mfma_f32_16x16x32_bf16(*(const LAS bf16x8*)(ab + 64 * s), *(const LAS bf16x8*)(bb + 64 * s), acc, 0, 0, 0);
#pragma unroll
                for (int e = 0; e < 4; ++e) { const int i = 16 * mi + 4 * fg + e; *(bf16*)(ops + GL_AI + (i * 64 + j) * 2) = (bf16)f2bf(i >= j ? acc[e] : 0.f); }
            } else {
#pragma unroll
                for (int e = 0; e < 4; ++e) { const int i = 16 * mi + 4 * fg + e; *(bf16*)(ops + GL_AI + (i * 64 + j) * 2) = (bf16)0; } } }
        { const int c = tid >> 1, tb = tid & 1; const float el = __expf(BC[63 * 256 + c]); float v[32];
#pragma unroll
          for (int e = 0; e < 32; ++e) v[e] = bf2f(*(const LAS bf16*)(lds + GLP_KPB + (32 * tb + e) * GLP_STR + 2 * c)) * el;
          v4u* dst = (v4u*)(ops + GL_KDT + c * 128 + 64 * tb);
#pragma unroll
          for (int e = 0; e < 4; ++e) { v4u o4; o4.x = pk2(v[8 * e], v[8 * e + 1]); o4.y = pk2(v[8 * e + 2], v[8 * e + 3]); o4.z = pk2(v[8 * e + 4], v[8 * e + 5]); o4.w = pk2(v[8 * e + 6], v[8 * e + 7]); dst[e] = o4; }
          if (tid < 256) ((float*)(ops + GL_DL))[tid] = __expf(BC[63 * 256 + tid]); }
        __syncthreads();
    }
}

constexpr int GS2_QP = 0, GS2_AI = 33792, GS2_KDT = 43008, GS2_DL = 79872, GS2_OT = 80896;
template <int PASS> __device__ __forceinline__ void gla_scan_phase(Frame& F, const unsigned char* OPS, float* E, float* DGP, bf16* OG) {
    if (blockIdx.x >= 256) return;
    const int tid = opaque_tid(), lane = tid & 63, w = F.wave, fr = lane & 15, fg = lane >> 4;
    const int idx = (F.G == 256) ? ((int)blockIdx.x & 7) * 32 + ((int)blockIdx.x >> 3) : (int)blockIdx.x;
    const int g = idx & 15, cb = (idx >> 4) & 3, h = idx >> 6;
    LAS unsigned char* lds = F.lds;
    const int colh = 128 * cb + 16 * w + fr;
    f32x4v Sf[16];
#pragma unroll
    for (int t = 0; t < 16; ++t) Sf[t] = (f32x4v){0.f, 0.f, 0.f, 0.f};
    const unsigned gof = (unsigned)tid * 16u;
    const unsigned lQ = (unsigned)((tid >> 5) * 528 + (tid & 31) * 16), lB = (unsigned)((tid >> 3) * 144 + (tid & 7) * 16);
    v4u pq[4], pa, pk[4], pd; v4u pv[2];
#define GL_LOAD(n) do { const unsigned char* o_ = OPS + (size_t)(h * 128 + (n)) * GL_UNIT; \
        if (PASS == 2) { _Pragma("unroll") for (int e_ = 0; e_ < 4; ++e_) pq[e_] = *(const v4u*)(o_ + GL_QP + gof + 8192 * e_); pa = *(const v4u*)(o_ + GL_AI + gof); } \
        _Pragma("unroll") for (int e_ = 0; e_ < 4; ++e_) pk[e_] = *(const v4u*)(o_ + GL_KDT + gof + 8192 * e_); \
        if (tid < 64) pd = *(const v4u*)(o_ + GL_DL + gof); \
        _Pragma("unroll") for (int s_ = 0; s_ < 2; ++s_) pv[s_] = *(const v4u*)(o_ + GL_VT + (size_t)colh * 128 + 64 * s_ + 16 * fg); } while (0)
    GL_LOAD(GCH * g);
    if (PASS == 2) {
        for (int gp = 0; gp < g; ++gp) { const float* ep = E + ((((size_t)(h * NGRP + gp) * 4 + cb) * 8 + w) * 16) * 256 + lane * 4; const float* dp = DGP + (size_t)(h * NGRP + gp) * 256;
#pragma unroll
            for (int t = 0; t < 16; ++t) { const f32x4v d4 = *(const f32x4v*)(dp + 16 * t + 4 * fg), e4 = *(const f32x4v*)(ep + t * 256); Sf[t] = Sf[t] * d4 + e4; } }
    }
#define GL_STORE() do { \
        if (PASS == 2) { _Pragma("unroll") for (int e_ = 0; e_ < 4; ++e_) *(LAS v4u*)(lds + GS2_QP + lQ + 16 * 528 * e_) = pq[e_]; *(LAS v4u*)(lds + GS2_AI + lB) = pa; } \
        _Pragma("unroll") for (int e_ = 0; e_ < 4; ++e_) *(LAS v4u*)(lds + GS2_KDT + lB + 64 * 144 * e_) = pk[e_]; \
        if (tid < 64) *(LAS v4u*)(lds + GS2_DL + gof) = pd; } while (0)
    const unsigned aQ = (unsigned)(fr * 528 + fg * 16), aB = (unsigned)(fr * 144 + fg * 16);
    float dprod = 1.0f;
    for (int nn = 0; nn < GCH; ++nn) {
        const int n = GCH * g + nn;
        LDS_BAR();
        GL_STORE();
        bf16x8 Vb[2]; Vb[0] = __builtin_bit_cast(bf16x8, pv[0]); Vb[1] = __builtin_bit_cast(bf16x8, pv[1]);
        LDS_BAR();
        if (nn + 1 < GCH) GL_LOAD(n + 1);
        if (PASS == 1 && cb == 0 && tid < 256) dprod *= *(const LAS float*)(lds + GS2_DL + 4 * tid);
        if (PASS == 2) {
            bf16x8 Sb[8];
#pragma unroll
            for (int s = 0; s < 8; ++s) { v4u t; t.x = cvtpk(Sf[2 * s][0], Sf[2 * s][1]); t.y = cvtpk(Sf[2 * s][2], Sf[2 * s][3]); t.z = cvtpk(Sf[2 * s + 1][0], Sf[2 * s + 1][1]); t.w = cvtpk(Sf[2 * s + 1][2], Sf[2 * s + 1][3]); Sb[s] = __builtin_bit_cast(bf16x8, t); }
            f32x4v oa[4];
#pragma unroll
            for (int m = 0; m < 4; ++m) oa[m] = (f32x4v){0.f, 0.f, 0.f, 0.f};
#pragma unroll
            for (int sp = 0; sp < 4; ++sp) { bf16x8 fq[8];
#pragma unroll
                for (int e = 0; e < 8; ++e) fq[e] = *(const LAS bf16x8*)(lds + GS2_QP + aQ + (e >> 1) * 16 * 528 + (2 * sp + (e & 1)) * 64);
                __builtin_amdgcn_sched_barrier(0);
#pragma unroll
                for (int e = 0; e < 8; ++e) { const int m_ = e & 3, ss_ = e >> 2; oa[m_] = __builtin_amdgcn_mfma_f32_16x16x32_bf16(fq[2 * m_ + ss_], Sb[2 * sp + ss_], oa[m_], 0, 0, 0); }
                __builtin_amdgcn_sched_barrier(0); }
            { bf16x8 fa[8];
#pragma unroll
              for (int e = 0; e < 8; ++e) fa[e] = *(const LAS bf16x8*)(lds + GS2_AI + aB + (e >> 1) * 16 * 144 + (e & 1) * 64);
              __builtin_amdgcn_sched_barrier(0);
#pragma unroll
              for (int e = 0; e < 8; ++e) { const int m_ = e & 3, ss_ = e >> 2; oa[m_] = __builtin_amdgcn_mfma_f32_16x16x32_bf16(fa[2 * m_ + ss_], Vb[ss_], oa[m_], 0, 0, 0); }
              __builtin_amdgcn_sched_barrier(0); }
#pragma unroll
            for (int m = 0; m < 4; ++m)
#pragma unroll
                for (int e = 0; e < 4; ++e) *(LAS bf16*)(lds + GS2_OT + (16 * m + 4 * fg + e) * 272 + (16 * w + fr) * 2) = (bf16)f2bf(oa[m][e]);
        }
#pragma unroll
        for (int tp = 0; tp < 4; ++tp) { bf16x8 fk[8]; f32x4v d4[4];
#pragma unroll
            for (int e = 0; e < 8; ++e) fk[e] = *(const LAS bf16x8*)(lds + GS2_KDT + aB + (4 * tp + (e >> 1)) * 16 * 144 + (e & 1) * 64);
#pragma unroll
            for (int tt = 0; tt < 4; ++tt) d4[tt] = *(const LAS f32x4v*)(lds + GS2_DL + (16 * (4 * tp + tt) + 4 * fg) * 4);
            __builtin_amdgcn_sched_barrier(0);
#pragma unroll
            for (int tt = 0; tt < 4; ++tt) Sf[4 * tp + tt] = Sf[4 * tp + tt] * d4[tt];
#pragma unroll
            for (int e = 0; e < 8; ++e) { const int tt_ = e & 3, ss_ = e >> 2; Sf[4 * tp + tt_] = __builtin_amdgcn_mfma_f32_16x16x32_bf16(fk[2 * tt_ + ss_], Vb[ss_], Sf[4 * tp + tt_], 0, 0, 0); }
            __builtin_amdgcn_sched_barrier(0); }
        if (PASS == 2) {
            LDS_BAR();
            const int t = tid >> 3, sg = tid & 7;
            const v4u r0 = *(const LAS v4u*)(lds + GS2_OT + t * 272 + sg * 32), r1 = *(const LAS v4u*)(lds + GS2_OT + t * 272 + sg * 32 + 16);
            bf16* op = OG + (size_t)(64 * n + t) * 2048 + h * 512 + 128 * cb + 16 * sg;
            *(v4u*)op = r0; *(v4u*)(op + 8) = r1;
        }
    }
#undef GL_LOAD
#undef GL_STORE
    if (PASS == 1) {
        float* ep = E + ((((size_t)(h * NGRP + g) * 4 + cb) * 8 + w) * 16) * 256 + lane * 4;
#pragma unroll
        for (int t = 0; t < 16; ++t) *(f32x4v*)(ep + t * 256) = Sf[t];
        if (cb == 0 && tid < 256) DGP[(size_t)(h * NGRP + g) * 256 + tid] = dprod;
    }
    __syncthreads();
}
#ifndef PROBE_KIND
#define PROBE_KIND 0
#endif
#define REPS(kind) ((PROBE_KIND == (kind) || ((kind) == 9 && (PROBE_KIND == 13 || PROBE_KIND == 14))) ? 2 : 1)
#define RUN(kind, ...) do { for (int rep_ = 0; rep_ < REPS(kind); ++rep_) { __VA_ARGS__; if (rep_ + 1 < REPS(kind)) xcd_barrier(bar); } } while (0)
constexpr int PPL = 10, NPH = 2 + PPL * NLAYER;
__global__ void __launch_bounds__(NWAVES * 64, 2) fwd(Args a) {
    extern __shared__ __attribute__((aligned(16))) unsigned char lds[];
    Frame F;
    F.lds = (LAS unsigned char*)lds; F.ldsg = lds; F.MISC = (volatile LAS unsigned*)(F.lds + MISC_OFF);
    F.wave = __builtin_amdgcn_readfirstlane((int)threadIdx.x >> 6);
    F.G = gridDim.x; F.gw = blockIdx.x * NWAVES + F.wave; F.NGW = F.G * NWAVES;
    F.ws = a.ws; F.ctl = (gu32*)(a.ws + WS_CTL);
    for (int u = threadIdx.x; u < (LDS_BYTES - LDSCTL_OFF) / 4; u += NWAVES * 64) ((LAS unsigned*)(F.lds + LDSCTL_OFF))[u] = 0u;
    __syncthreads();
    const int lo = a.ph_lo, hi = a.ph_hi;
    XcdBarrier bar; bar.bar = (unsigned*)(F.ctl + CW_BAR); bar.x = 0; bar.st = nullptr;
    if (hi - lo > 1) bar = xcd_barrier_post((unsigned*)(F.ctl + CW_BAR), F.MISC + 8);
#define IN(k) (lo <= (k) && (k) < hi)
#define SEAM(k) do { if (IN(k) && IN((k) + 1)) xcd_barrier(bar); } while (0)
    unsigned char* ws = a.ws;
    bf16* H = (bf16*)(ws + WS_H); bf16* MIX = (bf16*)(ws + WS_MIX); bf16* HID = (bf16*)(ws + WS_HID);
    float* SSQ = (float*)(ws + WS_SSQ); float* BA = (float*)(ws + WS_BA); const float* cosT = (const float*)(ws + WS_COS); const float* sinT = (const float*)(ws + WS_SIN);
    bf16* OG = (bf16*)(ws + WS_OG); const float* MODS = (const float*)(ws + WS_MODS);
    float* X = a.out;
    const int vcu = (F.G % 8 == 0) ? ((int)blockIdx.x % 8) * (F.G / 8) + (int)blockIdx.x / 8 : (int)blockIdx.x;

    if (IN(0)) { RUN(1, p0_prologue(F, a)); } SEAM(0);

    for (int L = 0; L < NLAYER; ++L) {
        const int base = 1 + PPL * L, i = L >> 1; const bool odd = (L & 1) != 0;
        const float* xin0 = (L == 0) ? (const float*)a.in[0] : (const float*)X;
        bf16* CQ = (bf16*)(ws + WS_PROJ); bf16* CKV = CQ + (size_t)TOK * 512; bf16* QKV = CKV + (size_t)TOK * 512; bf16* Z = QKV + (size_t)TOK * 3072;
        bf16* GQ = (bf16*)(ws + WS_PROJ); bf16* GK = GQ + (size_t)TOK * 1024; bf16* GV = GK + (size_t)TOK * 1024; bf16* GR = GV + (size_t)TOK * 2048;
        bf16* QH = (bf16*)(ws + WS_QH); bf16* KH = (bf16*)(ws + WS_KH); bf16* VT = (bf16*)(ws + WS_VT);
        unsigned char* GDOPS = ws + WS_SCR + 100 * MiB; unsigned char* GLOPS = ws + WS_SCR; float* GLE = (float*)(ws + WS_SCR + 72 * MiB); float* GLD = (float*)(ws + WS_SCR + 104 * MiB);

        if (IN(base + 0)) RUN(2, norm_phase<0>(F, a, xin0, (const float*)a.in[3] + (size_t)(2 * L) * DM, 2 * L, H, nullptr));
        SEAM(base + 0);
        if (IN(base + 1)) {
            if (!odd) { pg8::Gemm g{H, (const bf16*)(ws + WS_WEIN) + (size_t)i * EIN_NP * DM, TOK, EIN_NP, DM}; pg8::StaticOrder S; S.init(TOK, EIN_NP, F.G, (int)blockIdx.x);
                pg8::EpiEvenIn E{CQ, CKV, QKV, Z, KH, SSQ, BA, cosT, sinT};
                RUN(3, pg8::gemm_phase<pg8::EpiEvenIn, pg8::StaticOrder, true, true>(F.lds, g, S, E));
            } else { pg8::Gemm g{H, (const bf16*)(ws + WS_WOIN) + (size_t)i * OIN_NP * DM, TOK, OIN_NP, DM}; pg8::StaticOrder S; S.init(TOK, OIN_NP, F.G, (int)blockIdx.x);
                pg8::EpiOddIn E{GQ, GK, GV, GR};
                RUN(4, pg8::gemm_phase<pg8::EpiOddIn, pg8::StaticOrder, true, true>(F.lds, g, S, E)); }
        }
        SEAM(base + 1);
        if (IN(base + 2)) {
            if (!odd) { RUN(5,
                { pg8::Gemm g{CQ, (const bf16*)(ws + WS_WUQ) + (size_t)i * 1536 * 512, TOK, 1536, 512}; pg8::StaticOrder S; S.init(TOK, 1536, F.G, (int)blockIdx.x);
                  pg8::EpiUq E{QH, SSQ, cosT, sinT, 0.10411754112770776f};
                  pg8::gemm_phase<pg8::EpiUq, pg8::StaticOrder, true, true>(F.lds, g, S, E); }
                { pg8::Gemm g{CKV, (const bf16*)(ws + WS_WUKV) + (size_t)i * 2048 * 512, TOK, 2048, 512}; pg8::StaticOrder S; S.init(TOK, 2048, F.G, (int)blockIdx.x);
                  pg8::EpiUkv E{KH, VT, SSQ};
                  pg8::gemm_phase<pg8::EpiUkv, pg8::StaticOrder, true, true>(F.lds, g, S, E); }
                gdn_prep_phase(F, QKV, BA, (const float*)a.in[11] + (size_t)i * 4 * 3072, (const float*)a.in[12] + i * 8, (const float*)a.in[13] + i * 8, GDOPS));
            } else RUN(6, gla_prep_phase(F, H, (const bf16*)(ws + WS_WGL) + (size_t)i * 16 * DM, (const float*)a.in[17] + (size_t)i * 16 * 1024, (const float*)a.in[18] + i * 1024, GQ, GK, GV, GLOPS));
        }
        SEAM(base + 2);
        float* GDQ = (float*)(ws + WS_SCR + 192 * MiB); bf16* GDP = (bf16*)(ws + WS_SCR + 200 * MiB);
        if (IN(base + 3)) {
            if (!odd) { RUN(7, if (blockIdx.x < 256) { const int hh_ = (int)blockIdx.x >> 5, gg_ = ((int)blockIdx.x >> 1) & 15;
                    if (blockIdx.x & 1) gdn_scan_phase<1>(F, GDOPS, GDQ, GDP, nullptr, MIX, hh_, gg_); else gdn_scan_phase<0>(F, GDOPS, GDQ, GDP, nullptr, MIX, hh_, gg_); });
            } else RUN(8, gla_scan_phase<1>(F, GLOPS, GLE, GLD, OG));
        }
        SEAM(base + 3);
        if (IN(base + 4)) {
            if (!odd) { RUN(9,
                if (vcu < 128 && (PROBE_KIND != 14 || rep_ == 0)) gdn_scan_phase<2>(F, GDOPS, GDQ, GDP, (const float*)a.in[14] + i * 128, MIX, vcu >> 4, vcu & 15);
                if (PROBE_KIND != 13 || rep_ == 0) attn_phase(F, QH, KH, VT, MIX, (float*)(ws + WS_SCR), (float*)(ws + WS_SCR + AT_OPART_BYTES), vcu, 0));
            } else RUN(10, gla_scan_phase<2>(F, GLOPS, GLE, GLD, OG));
        }
        SEAM(base + 4);
        if (IN(base + 5)) { if (odd) RUN(11, gatenorm_phase(F, OG, (const float*)a.in[19] + i * 512, GR, MIX)); else { attn_merge_phase(F, (const float*)(ws + WS_SCR), (const float*)(ws + WS_SCR + AT_OPART_BYTES), MIX, 0); gdn_gate_phase(F, Z, MIX); } }
        SEAM(base + 5);
        if (IN(base + 6)) {
            const bf16* Wt = odd ? (const bf16*)(ws + WS_WOOUT) + (size_t)i * DM * DM : (const bf16*)(ws + WS_WEOUT) + (size_t)i * DM * DM;
            pg8::Gemm g{MIX, Wt, TOK, DM, DM}; pg8::StaticOrder S; S.init(TOK, DM, F.G, (int)blockIdx.x);
            pg8::EpiResid E{xin0, X, MODS + (size_t)(2 * L) * 2048};
            pg8::gemm_phase<pg8::EpiResid, pg8::StaticOrder, true, true>(F.lds, g, S, E);
        }
        SEAM(base + 6);
        if (IN(base + 7)) norm_phase<0>(F, a, X, (const float*)a.in[3] + (size_t)(2 * L + 1) * DM, 2 * L + 1, H, nullptr);
        SEAM(base + 7);
        if (IN(base + 8)) {
            pg8::Gemm g{H, (const bf16*)(ws + WS_W13) + (size_t)L * 2 * DFF * DM, TOK, 2 * DFF, DM}; pg8::StaticOrder S; S.init(TOK, 2 * DFF, F.G, (int)blockIdx.x);
            pg8::EpiFfnUp E{HID};
            RUN(12, pg8::gemm_phase<pg8::EpiFfnUp, pg8::StaticOrder, true, true>(F.lds, g, S, E));
        }
        SEAM(base + 8);
        if (IN(base + 9)) {
            pg8::Gemm g{HID, (const bf16*)(ws + WS_W2) + (size_t)L * DM * DFF, TOK, DM, DFF}; pg8::StaticOrder S; S.init(TOK, DM, F.G, (int)blockIdx.x);
            pg8::EpiResid E{X, X, MODS + (size_t)(2 * L + 1) * 2048};
            pg8::gemm_phase<pg8::EpiResid, pg8::StaticOrder, true, true>(F.lds, g, S, E);
        }
        SEAM(base + 9);
    }
    if (PROBE_KIND == 20) { for (int r_ = 0; r_ < 40; ++r_) xcd_barrier(bar); }
    if (IN(NPH - 1)) norm_phase<1>(F, a, X, (const float*)a.in[24], 0, nullptr, X);
#undef IN
#undef SEAM
}

extern "C" void kernel_launch(void* const* d_in, const int* in_sizes, int n_in, void* d_out, int out_size, void* d_ws, size_t ws_size, hipStream_t stream) {
    static int grid = 0;
    if (grid == 0) {
        if (n_in != 25 || out_size != TOK * DM || ws_size < WS_END) { fprintf(stderr, "kernel_launch: unexpected shapes (n_in %d, out %d, ws %zu < %zu)\n", n_in, out_size, ws_size, (size_t)WS_END); grid = -1; return; }
        int dev = 0, cus = 0;
        if (hipGetDevice(&dev) != hipSuccess || hipDeviceGetAttribute(&cus, hipDeviceAttributeMultiprocessorCount, dev) != hipSuccess) { grid = -1; return; }
        if (hipFuncSetAttribute((const void*)fwd, hipFuncAttributeMaxDynamicSharedMemorySize, LDS_BYTES) != hipSuccess) { fprintf(stderr, "kernel_launch: hipFuncSetAttribute failed\n"); grid = -1; return; }
        int per_cu = 0; (void)hipOccupancyMaxActiveBlocksPerMultiprocessor(&per_cu, (const void*)fwd, NWAVES * 64, LDS_BYTES); (void)hipGetLastError();
        if (per_cu < 1) fprintf(stderr, "kernel_launch: occupancy query reports %d blocks per CU\n", per_cu);
        grid = cus;
    }
    if (grid < 0) return;
    (void)hipMemsetAsync((char*)d_ws + WS_CTL, 0, CTL_ZERO_BYTES, stream);
    Args a{};
    for (int i = 0; i < 25; ++i) a.in[i] = d_in[i];
    a.out = (float*)d_out; a.ws = (unsigned char*)d_ws;
    auto run = [&](int lo, int hi) { a.ph_lo = lo; a.ph_hi = hi; hipLaunchKernelGGL(fwd, dim3(grid), dim3(NWAVES * 64), LDS_BYTES, stream, a); };
#if defined(MK_PER_PHASE)
    for (int p = 0; p < NPH; ++p) run(p, p + 1);
#else
    run(0, NPH);
#endif
}
```
